# Optimizing an MI355X kernel written in HIP

```python
import math
import jax, jax.numpy as jnp
from jax import lax
import numpy as np

D_MODEL = 2048
BATCH = 2
SEQ = 4096
DEPTH = 1

CHUNK = 64
D_MIX = D_MODEL
HEAD_DIM = 128
D_A = D_MIX // 2
D_B = D_MIX - D_A
H_A = D_A // HEAD_DIM
H_B = D_B // HEAD_DIM
LEFT_CHUNKS = 8
BAND = (LEFT_CHUNKS + 1) * CHUNK
MAX_REL = 128
IDX_H = 16
IDX_D = 64
TOPK_MAX = 256
Q_BLOCK = 128
EPS = 1e-6
SPLIT_SIZES = [D_A, D_A, D_A, D_A, D_B, D_B, D_B, D_B, IDX_H * IDX_D, IDX_D, IDX_H]
D_IN = sum(SPLIT_SIZES)

kernel_name = "hybrid_chunked_relpos_dsa_block"


def rms_norm(x, g):
    xf = x.astype(jnp.float32)
    y = xf * lax.rsqrt(jnp.mean(xf * xf, axis=-1, keepdims=True) + EPS)
    return (y * g.astype(jnp.float32)).astype(x.dtype)


def alibi_slopes(n_heads):
    return jnp.asarray([2.0 ** (-8.0 * (h + 1) / n_heads) for h in range(n_heads)], dtype=jnp.float32)


def chunked_relpos_attention(q, k, v, rel_bias):
    B, T, H, Dh = q.shape
    nc = T // CHUNK
    pad = LEFT_CHUNKS * CHUNK
    qc = q.reshape(B, nc, CHUNK, H, Dh)
    kp = jnp.pad(k, ((0, 0), (pad, 0), (0, 0), (0, 0)))
    vp = jnp.pad(v, ((0, 0), (pad, 0), (0, 0), (0, 0)))
    band = jnp.arange(nc)[:, None] * CHUNK + jnp.arange(BAND)[None, :]
    kb = kp[:, band]
    vb = vp[:, band]
    key_pos = band - pad
    q_pos = jnp.arange(T).reshape(nc, CHUNK)
    valid = key_pos >= 0
    rel = jnp.clip(q_pos[:, :, None] - key_pos[:, None, :], -MAX_REL, MAX_REL) + MAX_REL
    bias = rel_bias.astype(jnp.float32)[:, rel]
    s = jnp.einsum('bcqhd,bckhd->bhcqk', qc, kb).astype(jnp.float32) * (Dh ** -0.5) + bias[None]
    s = jnp.where(valid[None, None, :, None, :], s, -jnp.inf)
    p = jax.nn.softmax(s, axis=-1).astype(v.dtype)
    o = jnp.einsum('bhcqk,bckhd->bcqhd', p, vb)
    return o.reshape(B, T, H, Dh)


def dsa_sparse_attention(q, k, v, q_idx, k_idx, w_idx, slopes):
    B, T, H, Dh = q.shape
    top = min(TOPK_MAX, T // 4)
    nb = T // Q_BLOCK
    key_chunk = jnp.arange(T) // CHUNK
    idx_scale = (IDX_H ** -0.5) * (IDX_D ** -0.5)
    gather = jax.vmap(lambda arr, ii: arr[ii])

    def block(i):
        start = i * Q_BLOCK
        qb = lax.dynamic_slice_in_dim(q, start, Q_BLOCK, axis=1)
        qib = lax.dynamic_slice_in_dim(q_idx, start, Q_BLOCK, axis=1)
        wib = lax.dynamic_slice_in_dim(w_idx, start, Q_BLOCK, axis=1)
        q_pos = start + jnp.arange(Q_BLOCK)
        logits = jnp.einsum('bqhd,bsd->bqhs', qib, k_idx).astype(jnp.float32)
        score = jnp.einsum('bqh,bqhs->bqs', wib.astype(jnp.float32) * idx_scale, jax.nn.relu(logits))
        admissible = key_chunk[None, :] <= (q_pos // CHUNK)[:, None]
        score = jnp.where(admissible[None], score, -jnp.inf)
        sel_score, sel = lax.top_k(score, top)
        sel_valid = jnp.isfinite(sel_score)
        kg = gather(k, sel)
        vg = gather(v, sel)
        s = jnp.einsum('bqhd,bqjhd->bhqj', qb, kg).astype(jnp.float32) * (Dh ** -0.5)
        dist = jnp.abs(q_pos[None, :, None] - sel).astype(jnp.float32)
        s = s - slopes[None, :, None, None] * dist[:, None]
        s = jnp.where(sel_valid[:, None], s, -jnp.inf)
        p = jax.nn.softmax(s, axis=-1).astype(v.dtype)
        return jnp.einsum('bhqj,bqjhd->bqhd', p, vg)

    out = lax.map(block, jnp.arange(nb))
    return jnp.transpose(out, (1, 0, 2, 3, 4)).reshape(B, T, H, Dh)


def setup_inputs(seed: int = 0) -> dict:
    key = jax.random.key(seed)
    kx, kg, kin, krb, kout, kf = jax.random.split(key, 6)
    x = jax.random.normal(kx, (BATCH, SEQ, D_MODEL), jnp.float32)
    norm_gain = 1.0 + 0.01 * jax.random.normal(kg, (DEPTH, D_MODEL), jnp.float32)
    w_in = jax.random.normal(kin, (DEPTH, D_MODEL, D_IN), jnp.float32) * (D_MODEL ** -0.5)
    rel_bias = 0.5 * jax.random.normal(krb, (DEPTH, H_A, 2 * MAX_REL + 1), jnp.float32)
    w_out = jax.random.normal(kout, (DEPTH, D_MIX, D_MODEL), jnp.float32) * (D_MIX ** -0.5)
    final_gain = 1.0 + 0.01 * jax.random.normal(kf, (D_MODEL,), jnp.float32)
    return {"x": x, "norm_gain": norm_gain, "w_in": w_in, "rel_bias": rel_bias,
            "w_out": w_out, "final_gain": final_gain}


def reference(x, norm_gain, w_in, rel_bias, w_out, final_gain):
    B, T, _ = x.shape
    offsets = [int(o) for o in np.cumsum(SPLIT_SIZES)[:-1]]
    slopes = alibi_slopes(H_B)
    for l in range(DEPTH):
        h = rms_norm(x, norm_gain[l])
        proj = jnp.einsum('btd,de->bte', h, w_in[l])
        qa, ka, va, ga, qb, kb, vb, gb, qi, ki, wi = jnp.split(proj, offsets, axis=-1)
        heads = lambda t, n: t.reshape(B, T, n, HEAD_DIM)
        out_a = chunked_relpos_attention(heads(qa, H_A), heads(ka, H_A), heads(va, H_A), rel_bias[l])
        out_b = dsa_sparse_attention(heads(qb, H_B), heads(kb, H_B), heads(vb, H_B),
                                     qi.reshape(B, T, IDX_H, IDX_D), ki, wi, slopes)
        ya = out_a.reshape(B, T, D_A) * jax.nn.silu(ga)
        yb = out_b.reshape(B, T, D_B) * jax.nn.silu(gb)
        y = jnp.concatenate([ya, yb], axis=-1)
        x = x + jnp.einsum('bte,ed->btd', y, w_out[l])
    return rms_norm(x, final_gain)
```

```cpp
#include <hip/hip_runtime.h>
#include <hip/hip_bf16.h>
#include <cstdio>
#include <cstdint>
namespace pg8 {
#define PG8_LAS __attribute__((address_space(3)))
typedef unsigned short bf16_t;
typedef short bf16x8 __attribute__((ext_vector_type(8)));
typedef float f32x4 __attribute__((ext_vector_type(4)));
typedef unsigned u32x4 __attribute__((ext_vector_type(4)));
constexpr int BM = 256, BK = 64, HALF = 128, HTB = HALF * BK * 2  , STAGE_BYTES = 8 * HTB, NXCD = 8, WGM = 8;

__host__ __device__ __forceinline__ int lds_byte(int r, int c) { const int st = (r >> 4) * 2 + (c >> 5), rr = r & 15, cc = c & 31, ob = rr * 64 + cc * 2; return st * 1024 + (ob ^ (((ob >> 9) & 1) << 5)); }
__host__ __device__ __forceinline__ void stage_rc(int b, int& R, int& C) { const int st = b / 1024, sb = b % 1024, swz = sb ^ (((sb >> 9) & 1) << 5); R = (st >> 1) * 16 + swz / 64; C = (st & 1) * 32 + (swz % 64) / 2; }
__host__ __device__ __forceinline__ int perm32(int rho) { const int n = rho >> 4, i = rho & 15; return 8 * (i >> 2) + 4 * n + (i & 3); }

struct Unit { int pm, pn; };
struct Gemm { const bf16_t* A; const bf16_t* Bt; int M, N, K; };

struct StaticOrder {
    int nM, nN, nwg, G, c;
    __host__ __device__ void init(int M, int N, int G_, int c_) { nM = M / BM; nN = N / BM; nwg = nM * nN; G = G_; c = c_; }
    __host__ __device__ bool next(int i, Unit& u) const {
        const long L = (long)i * G + c; if (L >= nwg) return false;
        int wgid = (int)L; { const int q = nwg / NXCD, r = nwg % NXCD, xcd = wgid % NXCD, off = wgid / NXCD; wgid = (xcd < r ? xcd * (q + 1) : r * (q + 1) + (xcd - r) * q) + off; }
        const int nig = WGM * nN, gid = wgid / nig, fm = gid * WGM, gsz = (nM - fm) < WGM ? (nM - fm) : WGM;
        u.pm = fm + ((wgid % nig) % gsz); u.pn = (wgid % nig) / gsz; return true;
    }
    __device__ __forceinline__ void a_ready(const Unit&) const {}
    __device__ __forceinline__ void done(const Unit&) const {}
};

__device__ __forceinline__ unsigned cvt_pk_bf16(float lo, float hi) { unsigned r; asm volatile("v_cvt_pk_bf16_f32 %0, %1, %2" : "=v"(r) : "v"(lo), "v"(hi)); return r; }

struct EpiSplit {
    static constexpr bool PERM = true, AFTER_DRAIN = false;
    bf16_t* O; int ldc; int split_cols; size_t split_stride; float scale0;
    __device__ __forceinline__ void operator()(const f32x4 (&acc)[2][2][4][2], const Unit& u, int wr, int wc, int fr, int fq) const {
        const int row0 = u.pm * BM + wr * 64 + fr; int colt = u.pn * BM; bf16_t* base = O;
        float sc = 1.f; { const int t = colt / split_cols; base += (size_t)t * split_stride; colt -= t * split_cols; if (t == 0 || t == 4) sc = scale0; }
        const int col0 = colt + wc * 32 + 8 * fq;
#pragma unroll
        for (int ai = 0; ai < 2; ++ai)
#pragma unroll
            for (int m = 0; m < 4; ++m) { bf16_t* rowp = base + (size_t)(row0 + ai * HALF + m * 16) * ldc + col0;
#pragma unroll
                for (int bj = 0; bj < 2; ++bj) { f32x4 v0 = acc[ai][bj][m][0] * sc, v1 = acc[ai][bj][m][1] * sc;
                    u32x4 w; w.x = cvt_pk_bf16(v0[0], v0[1]); w.y = cvt_pk_bf16(v0[2], v0[3]); w.z = cvt_pk_bf16(v1[0], v1[1]); w.w = cvt_pk_bf16(v1[2], v1[3]);
                    *(u32x4*)(rowp + bj * HALF) = w; } }
    }
};
struct EpiResid {
    static constexpr bool PERM = false, AFTER_DRAIN = false;
    const float* base; float* out; float* part; int ldc;
    __device__ __forceinline__ void operator()(const f32x4 (&acc)[2][2][4][2], const Unit& u, int wr, int wc, int fr, int fq) const {
        const int col0 = u.pn * BM + wc * 32 + 4 * fq;
#pragma unroll
        for (int ai = 0; ai < 2; ++ai)
#pragma unroll
            for (int m = 0; m < 4; ++m) { const int r = u.pm * BM + ai * HALF + wr * 64 + m * 16 + fr; const size_t off = (size_t)r * ldc + col0; float ss = 0.f;
#pragma unroll
                for (int bj = 0; bj < 2; ++bj)
#pragma unroll
                    for (int n = 0; n < 2; ++n) { const f32x4 bs = *(const f32x4*)(base + off + bj * HALF + n * 16); const f32x4 o = bs + acc[ai][bj][m][n];
                        *(f32x4*)(out + off + bj * HALF + n * 16) = o; ss += (o[0] * o[0] + o[1] * o[1]) + (o[2] * o[2] + o[3] * o[3]); }
                ss += __shfl_xor(ss, 16); ss += __shfl_xor(ss, 32);
                if (fq == 0) part[(size_t)r * 32 + u.pn * 4 + wc] = ss; }
    }
};

template <class Epi, class Sched, bool ALIGN_EPI = false, bool SP2 = false>
__device__ __forceinline__ void gemm_phase(PG8_LAS unsigned char* lds, const Gemm g, const Sched& S, const Epi& E) {
    int tid_ = threadIdx.x; asm volatile("" : "+v"(tid_)); const int tid = tid_, wid = __builtin_amdgcn_readfirstlane(tid >> 6), lane = tid & 63, wr = wid >> 2, wc = wid & 3, fr = lane & 15, fq = lane >> 4;
    const int K = g.K, nt = K / BK;
    unsigned voffA[2], voffB[2];
#pragma unroll
    for (int i = 0; i < 2; ++i) { int R, C; stage_rc(tid * 16 + i * 8192, R, C); const int Rb = Epi::PERM ? ((R & ~31) + perm32(R & 31)) : R;
        voffA[i] = (unsigned)(R * K + C) * 2u; voffB[i] = (unsigned)(Rb * K + C) * 2u; }
    const size_t kstep = (size_t)(BK * 2);
    const size_t hstep = (size_t)HALF * K * 2;
    const size_t tstep = 2 * hstep;
    const unsigned ldsw = (unsigned)wid * 1024u;
    const int aoff = lds_byte(wr * 64 + fr, fq * 8), boff = lds_byte(wc * 32 + fr, fq * 8);
#define PG8_SA(b, h) (((b) * 2 + (h)) * HTB)
#define PG8_SB(b, h) ((4 + (b) * 2 + (h)) * HTB)
#define PG8_STAGE(bufoff, gbase, voff) do { _Pragma("unroll") for (int _i = 0; _i < 2; ++_i) \
        __builtin_amdgcn_global_load_lds((const unsigned*)((const char*)(gbase) + (voff)[_i]), (PG8_LAS unsigned*)(lds + (bufoff) + ldsw + _i * 8192), 16, 0, 0); } while (0)
#define PG8_LDA(dst, b, h) do { _Pragma("unroll") for (int m = 0; m < 4; ++m) _Pragma("unroll") for (int k = 0; k < 2; ++k) dst[m][k] = *(const PG8_LAS bf16x8*)(lds + PG8_SA(b, h) + aoff + m * 2048 + k * 1024); } while (0)
#define PG8_LDB(dst, b, h) do { _Pragma("unroll") for (int n = 0; n < 2; ++n) _Pragma("unroll") for (int k = 0; k < 2; ++k) dst[n][k] = *(const PG8_LAS bf16x8*)(lds + PG8_SB(b, h) + boff + n * 2048 + k * 1024); } while (0)
#define PG8_MMA(ai, bj, At, Bt) do { __builtin_amdgcn_s_setprio(1); _Pragma("unroll") for (int m = 0; m < 4; ++m) _Pragma("unroll") for (int n = 0; n < 2; ++n) _Pragma("unroll") for (int k = 0; k < 2; ++k) \
        acc[ai][bj][m][n] = __builtin_amdgcn_mfma_f32_16x16x32_bf16(Bt[n][k], At[m][k], acc[ai][bj][m][n], 0, 0, 0); __builtin_amdgcn_s_setprio(0); } while (0)
#define PG8_WAIT_V(n) asm volatile("s_waitcnt vmcnt(" #n ")" ::: "memory")
#define PG8_WAIT_L(n) asm volatile("s_waitcnt lgkmcnt(" #n ")" ::: "memory")
#define PG8_BAR __builtin_amdgcn_s_barrier()
#define PG8_SCHED __builtin_amdgcn_sched_barrier(0)
    Unit cur, nxt; int ui = 0;
    if (!S.next(0, cur)) return;
    f32x4 acc[2][2][4][2];
#pragma unroll
    for (int a = 0; a < 2; ++a)
#pragma unroll
        for (int b = 0; b < 2; ++b)
#pragma unroll
            for (int m = 0; m < 4; ++m)
#pragma unroll
                for (int n = 0; n < 2; ++n) acc[a][b][m][n] = (f32x4){0.f, 0.f, 0.f, 0.f};
    bf16x8 At[4][2], B0[2][2], B1[2][2];
    const char* cA = (const char*)g.A + (size_t)cur.pm * tstep; const char* cB = (const char*)g.Bt + (size_t)cur.pn * tstep;
    S.a_ready(cur);
    if constexpr (SP2) {
        PG8_STAGE(PG8_SB(0, 0), cB, voffB); PG8_STAGE(PG8_SB(0, 1), cB + hstep, voffB); PG8_STAGE(PG8_SA(0, 0), cA, voffA); PG8_STAGE(PG8_SA(0, 1), cA + hstep, voffA);
        if (wr == 1) PG8_BAR;
        PG8_WAIT_V(2); PG8_BAR;
        PG8_STAGE(PG8_SB(1, 0), cB + kstep, voffB); PG8_STAGE(PG8_SA(1, 0), cA + kstep, voffA); PG8_STAGE(PG8_SB(1, 1), cB + hstep + kstep, voffB);
        PG8_WAIT_V(6); PG8_BAR;
    } else {
        PG8_STAGE(PG8_SB(0, 0), cB, voffB); PG8_STAGE(PG8_SA(0, 0), cA, voffA); PG8_STAGE(PG8_SB(0, 1), cB + hstep, voffB); PG8_STAGE(PG8_SA(0, 1), cA + hstep, voffA);
        if (wr == 1) PG8_BAR;
        PG8_WAIT_V(4); PG8_BAR;
        PG8_STAGE(PG8_SB(1, 0), cB + kstep, voffB); PG8_STAGE(PG8_SA(1, 0), cA + kstep, voffA); PG8_STAGE(PG8_SB(1, 1), cB + hstep + kstep, voffB);
        PG8_WAIT_V(6); PG8_BAR;
    }
    for (;;) {
        const bool has_next = S.next(ui + 1, nxt);
        const char* nA = has_next ? (const char*)g.A + (size_t)nxt.pm * tstep : cA; const char* nB = has_next ? (const char*)g.Bt + (size_t)nxt.pn * tstep : cB;
        for (int t = 0; t < nt; t += 2) {
            const bool last = (t == nt - 2);
            const char* a1 = cA + (size_t)(t + 1) * kstep;
            const char* a2 = last ? nA : cA + (size_t)(t + 2) * kstep; const char* b2 = last ? nB : cB + (size_t)(t + 2) * kstep;
            const char* a3 = a2 + kstep; const char* b3 = b2 + kstep;
            if (last && has_next) S.a_ready(nxt);
            if constexpr (SP2) {
            PG8_LDB(B0, 0, 0); PG8_LDB(B1, 0, 1); PG8_SCHED; PG8_LDA(At, 0, 0); PG8_STAGE(PG8_SA(1, 1), a1 + hstep, voffA);
            PG8_WAIT_V(8); PG8_WAIT_L(0); PG8_BAR; PG8_MMA(0, 0, At, B0); PG8_MMA(0, 1, At, B1); PG8_BAR; PG8_SCHED;
            PG8_LDA(At, 0, 1); PG8_STAGE(PG8_SB(0, 0), b2, voffB); PG8_STAGE(PG8_SB(0, 1), b2 + hstep, voffB); PG8_STAGE(PG8_SA(0, 0), a2, voffA);
            PG8_WAIT_V(8); PG8_WAIT_L(0); PG8_BAR; PG8_MMA(1, 0, At, B0); PG8_MMA(1, 1, At, B1); PG8_BAR; PG8_SCHED;
            PG8_LDB(B0, 1, 0); PG8_LDB(B1, 1, 1); PG8_SCHED; PG8_LDA(At, 1, 0); PG8_STAGE(PG8_SA(0, 1), a2 + hstep, voffA);
            PG8_WAIT_V(8); PG8_WAIT_L(0); PG8_BAR; PG8_MMA(0, 0, At, B0); PG8_MMA(0, 1, At, B1); PG8_BAR; PG8_SCHED;
            PG8_LDA(At, 1, 1); PG8_STAGE(PG8_SB(1, 0), b3, voffB); PG8_STAGE(PG8_SB(1, 1), b3 + hstep, voffB); PG8_STAGE(PG8_SA(1, 0), a3, voffA);
            PG8_WAIT_V(8); PG8_WAIT_L(0); PG8_BAR; PG8_MMA(1, 0, At, B0); PG8_MMA(1, 1, At, B1); PG8_BAR; PG8_SCHED;
            } else {
            PG8_LDB(B0, 0, 0); PG8_SCHED; PG8_LDA(At, 0, 0); PG8_STAGE(PG8_SA(1, 1), a1 + hstep, voffA);
            PG8_WAIT_L(8); PG8_BAR; PG8_WAIT_L(0); PG8_MMA(0, 0, At, B0); PG8_BAR; PG8_SCHED;
            PG8_LDB(B1, 0, 1); PG8_STAGE(PG8_SB(0, 0), b2, voffB);
            PG8_BAR; PG8_WAIT_L(0); PG8_MMA(0, 1, At, B1); PG8_BAR;
            PG8_LDA(At, 0, 1); PG8_STAGE(PG8_SA(0, 0), a2, voffA);
            PG8_BAR; PG8_WAIT_L(0); PG8_MMA(1, 0, At, B0); PG8_BAR; PG8_SCHED;
            PG8_STAGE(PG8_SB(0, 1), b2 + hstep, voffB);
            PG8_WAIT_V(6); PG8_BAR; PG8_MMA(1, 1, At, B1); PG8_BAR;
            PG8_LDB(B0, 1, 0); PG8_SCHED; PG8_LDA(At, 1, 0); PG8_STAGE(PG8_SA(0, 1), a2 + hstep, voffA);
            PG8_WAIT_L(8); PG8_BAR; PG8_WAIT_L(0); PG8_MMA(0, 0, At, B0); PG8_BAR; PG8_SCHED;
            PG8_LDB(B1, 1, 1); PG8_STAGE(PG8_SB(1, 0), b3, voffB);
            PG8_BAR; PG8_WAIT_L(0); PG8_MMA(0, 1, At, B1); PG8_BAR;
            PG8_LDA(At, 1, 1); PG8_STAGE(PG8_SA(1, 0), a3, voffA);
            PG8_BAR; PG8_WAIT_L(0); PG8_MMA(1, 0, At, B0); PG8_BAR; PG8_SCHED;
            PG8_STAGE(PG8_SB(1, 1), b3 + hstep, voffB);
            PG8_WAIT_V(6); PG8_BAR; PG8_MMA(1, 1, At, B1); PG8_BAR;
            }
        }
        if constexpr (ALIGN_EPI) { if (wr == 0) PG8_BAR; }
        if constexpr (!Epi::AFTER_DRAIN) { E(acc, cur, wr, wc, fr, fq); S.done(cur); }
        if (!has_next) break;
#pragma unroll
        for (int a = 0; a < 2; ++a)
#pragma unroll
            for (int b = 0; b < 2; ++b)
#pragma unroll
                for (int m = 0; m < 4; ++m)
#pragma unroll
                    for (int n = 0; n < 2; ++n) acc[a][b][m][n] = (f32x4){0.f, 0.f, 0.f, 0.f};
        cur = nxt; cA = nA; cB = nB; ++ui;
        if constexpr (ALIGN_EPI) { if (wr == 1) PG8_BAR; }
    }
    PG8_WAIT_V(0);
    if constexpr (!ALIGN_EPI) { if (wr == 0) PG8_BAR; }
    PG8_BAR;
    if constexpr (Epi::AFTER_DRAIN) { E.fused(acc, cur, wr, wc, fr, fq, lds, wid, lane); S.done(cur); }
#undef PG8_SA
#undef PG8_SB
#undef PG8_STAGE
#undef PG8_LDA
#undef PG8_LDB
#undef PG8_MMA
#undef PG8_WAIT_V
#undef PG8_WAIT_L
#undef PG8_BAR
#undef PG8_SCHED
}
}
namespace att {
typedef unsigned short u16;
typedef short bf16x8 __attribute__((ext_vector_type(8)));
typedef short s16x4 __attribute__((ext_vector_type(4)));
typedef float f32x16 __attribute__((ext_vector_type(16)));
typedef float f32x4 __attribute__((ext_vector_type(4)));
typedef unsigned u32x4 __attribute__((ext_vector_type(4)));
typedef unsigned u32x2 __attribute__((ext_vector_type(2)));
constexpr int D = 128, NW = 8, QBLK = 32, KVBLK = 64, QB = NW * QBLK;
constexpr int PITCH = 1024;
constexpr int YPITCH = 2048;
constexpr int SEQ = 4096;
constexpr int SHM_V = KVBLK * D * 2, SHM_K = KVBLK * D * 2;
constexpr int LDS_WS = 2 * SHM_V + 2 * SHM_K;
constexpr int LDS_BT = LDS_WS + NW * 64 * 4;
constexpr int LDS_BYTES = LDS_BT + 1280;
constexpr float THR = 8.f;

#define KSWZ(row, colB) ((row) * 256 + ((colB) ^ (((row) & 7) << 4)))
#define SBAR() __builtin_amdgcn_sched_barrier(0)
__device__ __forceinline__ int v_st(int k, int c) { const int kk = (k & ~0xC) | ((k & 4) << 1) | ((k & 8) >> 1); return ((kk >> 3) * 4 + (c >> 5)) * 512 + ((kk & 7) * 32 + (c & 31)) * 2; }
__device__ __forceinline__ int v_rd_base(int lane) { return ((lane & 3) << 3) | (((lane >> 2) & 3) << 6) | (((lane >> 4) & 1) << 5) | (((lane >> 5) & 1) << 8); }
constexpr int v_rd_off(int d0, int ks, int half) { return d0 * 512 + ks * 4096 + half * 2048; }
__device__ __forceinline__ int crow(int r, int hi) { return (r & 3) + 8 * (r >> 2) + 4 * hi; }
__device__ __forceinline__ unsigned cvtpk(float lo, float hi) { unsigned r; asm volatile("v_cvt_pk_bf16_f32 %0, %1, %2" : "=v"(r) : "v"(lo), "v"(hi)); return r; }
__device__ __forceinline__ bf16x8 load8(const u16* p) { return *reinterpret_cast<const bf16x8*>(p); }
__device__ __forceinline__ float bf2f(unsigned h) { return __uint_as_float(h << 16); }

__device__ __forceinline__ void partialSM(f32x16& p0, f32x16& p1, float& m_reg, float& alpha) {
    float pmax = p0[0];
#pragma unroll
    for (int r = 1; r < 16; ++r) pmax = fmaxf(pmax, p0[r]);
#pragma unroll
    for (int r = 0; r < 16; ++r) pmax = fmaxf(pmax, p1[r]);
    { auto rr = __builtin_amdgcn_permlane32_swap(__float_as_uint(pmax), __float_as_uint(pmax), false, false);
      pmax = fmaxf(__uint_as_float(rr[0]), __uint_as_float(rr[1])); }
    float mn;
    if (__builtin_expect(__all((pmax - m_reg) <= THR), 1)) { mn = m_reg; alpha = 1.f; }
    else { mn = fmaxf(m_reg, pmax); alpha = __builtin_amdgcn_exp2f(m_reg - mn); m_reg = mn; }
#pragma unroll
    for (int r = 0; r < 16; ++r) p0[r] = p0[r] - mn;
#pragma unroll
    for (int r = 0; r < 16; ++r) p1[r] = p1[r] - mn;
#pragma unroll
    for (int r = 0; r < 16; ++r) p0[r] = __builtin_amdgcn_exp2f(p0[r]);
}
__device__ __forceinline__ void finishSM(f32x16& p0, f32x16& p1, float alpha, float& l_reg, bf16x8& pa0, bf16x8& pa1, bf16x8& pa2, bf16x8& pa3) {
#pragma unroll
    for (int r = 0; r < 16; ++r) p1[r] = __builtin_amdgcn_exp2f(p1[r]);
    float ps = 0;
#pragma unroll
    for (int r = 0; r < 16; ++r) ps += p0[r];
#pragma unroll
    for (int r = 0; r < 16; ++r) ps += p1[r];
    { auto rr = __builtin_amdgcn_permlane32_swap(__float_as_uint(ps), __float_as_uint(ps), false, false);
      ps = __uint_as_float(rr[0]) + __uint_as_float(rr[1]); }
    l_reg = l_reg * alpha + ps;
#define PK4(P, B_, OUT) do { unsigned a0 = cvtpk(P[B_+0], P[B_+1]), a1 = cvtpk(P[B_+2], P[B_+3]);                          \
        unsigned b0 = cvtpk(P[B_+4], P[B_+5]), b1 = cvtpk(P[B_+6], P[B_+7]);                                             \
        auto r0 = __builtin_amdgcn_permlane32_swap(a0, b0, false, false); auto r1 = __builtin_amdgcn_permlane32_swap(a1, b1, false, false); \
        u32x4 w = {r0[0], r1[0], r0[1], r1[1]}; OUT = *reinterpret_cast<bf16x8*>(&w); } while (0)
    PK4(p0, 0, pa0); PK4(p0, 8, pa1); PK4(p1, 0, pa2); PK4(p1, 8, pa3);
#undef PK4
}
template <int KB>
__device__ __forceinline__ void qkt(f32x16& p0, f32x16& p1, const char* K_lds, int r32, int hi, const bf16x8* qr, bool act) {
    if (!act) { const float NEG = -__builtin_inff();
#pragma unroll
        for (int r = 0; r < 16; ++r) { p0[r] = NEG; p1[r] = NEG; } return; }
    p0 = f32x16{}; p1 = f32x16{};
    const char* kb[4];
#pragma unroll
    for (int dd = 0; dd < 4; ++dd) kb[dd] = K_lds + KB * SHM_K + KSWZ(r32, (dd * 16 + hi * 8) * 2);
#pragma unroll
    for (int d0 = 0; d0 < 8; ++d0) { const char* a = kb[d0 & 3] + (d0 >> 2) * 128;
        bf16x8 b0 = *reinterpret_cast<const bf16x8*>(a);
        bf16x8 b1 = *reinterpret_cast<const bf16x8*>(a + 32 * 256);
        p0 = __builtin_amdgcn_mfma_f32_32x32x16_bf16(b0, qr[d0], p0, 0, 0, 0);
        p1 = __builtin_amdgcn_mfma_f32_32x32x16_bf16(b1, qr[d0], p1, 0, 0, 0); }
}
template <int VB>
__device__ __forceinline__ void pv_tile(f32x16* o, int vb0, bf16x8 pa0, bf16x8 pa1, bf16x8 pa2, bf16x8 pa3, bool act) {
    if (!act) return;
#define TRRD(dst, off) asm volatile("ds_read_b64_tr_b16 %0, %1 offset:%2" : "=&v"(dst) : "v"(vb0), "i"(off) : "memory")
#define PV_D0(d0) do { s16x4 l0, l1, l2, l3, h0, h1, h2, h3; constexpr int b_ = VB * SHM_V + v_rd_off(d0, 0, 0); \
        TRRD(l0, b_); TRRD(h0, b_ + 2048); TRRD(l1, b_ + 4096); TRRD(h1, b_ + 6144); TRRD(l2, b_ + 8192); TRRD(h2, b_ + 10240); TRRD(l3, b_ + 12288); TRRD(h3, b_ + 14336); \
        asm volatile("s_waitcnt lgkmcnt(0)" ::: "memory"); SBAR(); \
        o[d0] = __builtin_amdgcn_mfma_f32_32x32x16_bf16(pa0, (bf16x8){l0[0], l0[1], l0[2], l0[3], h0[0], h0[1], h0[2], h0[3]}, o[d0], 0, 0, 0);   \
        o[d0] = __builtin_amdgcn_mfma_f32_32x32x16_bf16(pa1, (bf16x8){l1[0], l1[1], l1[2], l1[3], h1[0], h1[1], h1[2], h1[3]}, o[d0], 0, 0, 0);   \
        o[d0] = __builtin_amdgcn_mfma_f32_32x32x16_bf16(pa2, (bf16x8){l2[0], l2[1], l2[2], l2[3], h2[0], h2[1], h2[2], h2[3]}, o[d0], 0, 0, 0);   \
        o[d0] = __builtin_amdgcn_mfma_f32_32x32x16_bf16(pa3, (bf16x8){l3[0], l3[1], l3[2], l3[3], h3[0], h3[1], h3[2], h3[3]}, o[d0], 0, 0, 0); } while (0)
    PV_D0(0); PV_D0(1); PV_D0(2); PV_D0(3);
#undef PV_D0
#undef TRRD
}

struct BlockRef { const u16* Q; const u16* K; const u16* V; const u16* G; u16* Y; const unsigned long long* M; int P0; float nslope; };
struct Seam { bf16x8 qr[8]; bf16x8 st_v0, st_v1, st_k0, st_k1; };
template <int MODE> __device__ __forceinline__ int blk_jlo(int P0) { if (MODE == 0) { const int c = P0 / KVBLK - 8; return c > 0 ? c : 0; } return 0; }
#define ROW(p, k0, rr) ((p) + (size_t)((k0) + (rr)) * PITCH + sc)
#define VMW() asm volatile("s_waitcnt vmcnt(0)" ::: "memory")
#define VMWN(n) asm volatile("s_waitcnt vmcnt(%0)" :: "i"(n) : "memory")
#define SLOAD_H(Kp, Vp, k0) do { S.st_v0 = load8(ROW(Vp, k0, sr)); S.st_v1 = load8(ROW(Vp, k0, 32 + sr));              \
                         S.st_k0 = load8(ROW(Kp, k0, sr)); S.st_k1 = load8(ROW(Kp, k0, 32 + sr)); } while (0)
#define SWRITE_HK(bf) do { *(bf16x8*)(K_lds + (bf) * SHM_K + kws) = S.st_k0; *(bf16x8*)(K_lds + (bf) * SHM_K + kws + 32 * 256) = S.st_k1; } while (0)
#define SWRITE_HV(bf) do { *(bf16x8*)(V_lds + (bf) * SHM_V + vst0) = S.st_v0; *(bf16x8*)(V_lds + (bf) * SHM_V + vst1) = S.st_v1; } while (0)
#define SWRITE_H(bf) do { SWRITE_HV(bf); SWRITE_HK(bf); } while (0)
template <int MODE>
__device__ __forceinline__ void attn_prime(const BlockRef& cur, char* lds, Seam& S) {
    int tid_ = threadIdx.x; asm volatile("" : "+v"(tid_)); const int tid = tid_, wid = __builtin_amdgcn_readfirstlane(tid >> 6), lane = tid & 63, r32 = lane & 31, hi = lane >> 5;
    const int sr = tid >> 4, sc = (tid & 15) * 8, kws = KSWZ(sr, sc * 2); char* K_lds = lds + 2 * SHM_V;
    const int kb0 = blk_jlo<MODE>(cur.P0) * KVBLK;
#pragma unroll
    for (int d0 = 0; d0 < 8; ++d0) S.qr[d0] = load8(cur.Q + (size_t)(cur.P0 + wid * QBLK + r32) * PITCH + d0 * 16 + hi * 8);
    SLOAD_H(cur.K, cur.V, kb0); VMW(); SWRITE_HK(0);
    __syncthreads();
}
template <int MODE>
__device__ __forceinline__ void modify(f32x16& p0, f32x16& p1, int jt, int cw, int qpos, int hi, const float* bt, float nslope, u32x2 mw) {
    const int rel0 = qpos - jt * KVBLK - 4 * hi;
    if (MODE == 0) {
        if (jt <= cw - 3) { const float cb = bt[256];
#pragma unroll
            for (int r = 0; r < 16; ++r) { p0[r] += cb; p1[r] += cb; } }
        else {
#pragma unroll
            for (int r = 0; r < 16; ++r) { const int c = (r & 3) + 8 * (r >> 2);
                int i0 = rel0 - c, i1 = rel0 - c - 32;
                i0 = i0 < -128 ? -128 : (i0 > 128 ? 128 : i0); i1 = i1 < -128 ? -128 : (i1 > 128 ? 128 : i1);
                p0[r] += bt[i0 + 128]; p1[r] += bt[i1 + 128]; } }
    } else {
        const float NEG = -__builtin_inff();
        const float fq = (float)rel0;
        const unsigned w0 = mw.x >> (4 * hi), w1 = mw.y >> (4 * hi);
#pragma unroll
        for (int r = 0; r < 16; ++r) { const int c = (r & 3) + 8 * (r >> 2);
            const float t0 = fq - (float)c, t1 = fq - (float)(c + 32);
            float a0 = fmaf(fabsf(t0), nslope, p0[r]), a1 = fmaf(fabsf(t1), nslope, p1[r]);
            p0[r] = ((w0 >> c) & 1u) ? a0 : NEG; p1[r] = ((w1 >> c) & 1u) ? a1 : NEG; }
    }
}
template <int MODE>
__device__ __forceinline__ void attn_block(const BlockRef& cur, const BlockRef& nxt, char* lds, Seam& S) {
    int tid_ = threadIdx.x; asm volatile("" : "+v"(tid_)); const int tid = tid_, wid = __builtin_amdgcn_readfirstlane(tid >> 6), lane = tid & 63, r32 = lane & 31, hi = lane >> 5;
    const int j_lo = blk_jlo<MODE>(cur.P0);
    const int j_hi = cur.P0 / KVBLK + 4;
    const int NT = j_hi - j_lo;
    const int kbn = blk_jlo<MODE>(nxt.P0) * KVBLK;
    const int cw = cur.P0 / KVBLK + (wid >> 1);
    const int qpos = cur.P0 + wid * QBLK + r32;
    char* V_lds = lds; char* K_lds = lds + 2 * SHM_V;
    float* ws = (float*)(lds + LDS_WS) + wid * 64; float* li_l = ws, * al_l = ws + 32;
    const float* bt = (const float*)(lds + LDS_BT);
    float m_reg = -1e30f, l_reg = 0; f32x16 o[4] = {};
    const int sr = tid >> 4, sc = (tid & 15) * 8, vst0 = v_st(sr, sc), vst1 = v_st(32 + sr, sc), kws = KSWZ(sr, sc * 2);
    const int vb0 = (int)(uintptr_t)V_lds + v_rd_base(lane);
    const u16* Kh = cur.K; const u16* Vh = cur.V;
    const unsigned long long* mrow = cur.M + qpos;
#define RESC(a) do { if (__any((a) < 1.f)) { if (hi == 0) al_l[r32] = (a); asm volatile("s_waitcnt lgkmcnt(0)" ::: "memory");              \
                     for (int d_ = 0; d_ < 4; ++d_) for (int r = 0; r < 16; ++r) o[d_][r] *= al_l[crow(r, hi)]; } } while (0)
#define KBASE(t) ((j_lo + (t)) * KVBLK)
#define ACT(t) (MODE == 0 ? ((j_lo + (t)) <= cw && (j_lo + (t)) >= cw - 8) : ((j_lo + (t)) <= cw))
#define MLOAD(t) ((MODE == 1 && ACT(t)) ? *(const u32x2*)(mrow + (size_t)(j_lo + (t)) * SEQ) : (u32x2){0u, 0u})
#define MODT(P0_, P1_, t, MW) do { if (ACT(t)) modify<MODE>(P0_, P1_, j_lo + (t), cw, qpos, hi, bt, cur.nslope, MW); } while (0)
#define SEAM_K0() do { VMWN(8); SWRITE_HK(0); SBAR(); } while (0)
    f32x16 pA0, pA1, pB0, pB1; float alA, alB; bf16x8 pa0, pa1, pa2, pa3; u32x2 mwA, mwB;
    SWRITE_HV(0); SBAR();
    mwA = MLOAD(0);
    if (NT > 1) { SLOAD_H(Kh, Vh, KBASE(1)); }
    SBAR(); qkt<0>(pA0, pA1, K_lds, r32, hi, S.qr, ACT(0));
    MODT(pA0, pA1, 0, mwA); partialSM(pA0, pA1, m_reg, alA);
    if (NT > 1) { VMW(); SWRITE_H(1); }
    __syncthreads();
#define HALF_STEP(PX0, PX1, alX, mwX, PY0, PY1, alY, t, KB, VB, SB) do {                                                      \
        SBAR(); mwX = MLOAD(t); qkt<KB>(PX0, PX1, K_lds, r32, hi, S.qr, ACT(t));                                             \
        finishSM(PY0, PY1, alY, l_reg, pa0, pa1, pa2, pa3); SBAR();                                                           \
        if ((t) + 1 < NT) { SLOAD_H(Kh, Vh, KBASE((t) + 1)); SBAR(); }                                                        \
        pv_tile<VB>(o, vb0, pa0, pa1, pa2, pa3, ACT((t) - 1)); MODT(PX0, PX1, (t), mwX); partialSM(PX0, PX1, m_reg, alX);    \
        __syncthreads();                                                                                                      \
        if ((t) + 1 < NT) { VMW(); SWRITE_H(SB); }                                                                            \
        RESC(alX); __syncthreads(); } while (0)
    for (int t = 1; t + 1 < NT; t += 2) {
        HALF_STEP(pB0, pB1, alB, mwB, pA0, pA1, alA, t, 1, 0, 0);
        HALF_STEP(pA0, pA1, alA, mwA, pB0, pB1, alB, t + 1, 0, 1, 1);
    }
    const bool even = (NT & 1) == 0;
    if (even) { SBAR(); mwB = MLOAD(NT - 1); qkt<1>(pB0, pB1, K_lds, r32, hi, S.qr, ACT(NT - 1)); SBAR(); }
    SLOAD_H(nxt.K, nxt.V, kbn); SBAR();
#pragma unroll
    for (int d0 = 0; d0 < 8; ++d0) S.qr[d0] = load8(nxt.Q + (size_t)(nxt.P0 + wid * QBLK + r32) * PITCH + d0 * 16 + hi * 8);
    SBAR();
    finishSM(pA0, pA1, alA, l_reg, pa0, pa1, pa2, pa3); SBAR();
    pv_tile<0>(o, vb0, pa0, pa1, pa2, pa3, ACT(even ? NT - 2 : NT - 1));
    if (even) { MODT(pB0, pB1, NT - 1, mwB); partialSM(pB0, pB1, m_reg, alB); __syncthreads(); RESC(alB);
        finishSM(pB0, pB1, alB, l_reg, pa0, pa1, pa2, pa3); SBAR(); pv_tile<1>(o, vb0, pa0, pa1, pa2, pa3, ACT(NT - 1)); }
    SBAR(); SEAM_K0();
    if (hi == 0) li_l[r32] = l_reg; asm volatile("s_waitcnt lgkmcnt(0)" ::: "memory");
    float rli[16];
#pragma unroll
    for (int r = 0; r < 16; ++r) rli[r] = __builtin_amdgcn_rcpf(li_l[crow(r, hi)]);
    const size_t row0 = (size_t)(cur.P0 + wid * QBLK);
#pragma unroll
    for (int r = 0; r < 16; ++r) { const int orow = crow(r, hi);
        const u16* gp = cur.G + (row0 + orow) * PITCH; u16* yp = cur.Y + (row0 + orow) * YPITCH;
#pragma unroll
        for (int d0 = 0; d0 < 4; ++d0) { const int col = d0 * 32 + r32;
            const unsigned gw = *(const unsigned*)(gp + (col & ~1));
            const float g = (col & 1) ? __uint_as_float(gw & 0xffff0000u) : __uint_as_float(gw << 16);
            const float sg = g * __builtin_amdgcn_rcpf(1.f + __builtin_amdgcn_exp2f(-1.4426950408889634f * g));
            const float v = o[d0][r] * rli[r] * sg;
            const float vn = __shfl_xor(v, 1);
            if ((r32 & 1) == 0) *(unsigned*)(yp + col) = cvtpk(v, vn); } }
    __syncthreads();
#undef RESC
#undef KBASE
#undef ACT
#undef MLOAD
#undef MODT
#undef SEAM_K0
#undef HALF_STEP
}
#undef ROW
#undef VMW
#undef VMWN
#undef SLOAD_H
#undef SWRITE_HK
#undef SWRITE_HV
#undef SWRITE_H
#undef SBAR
#undef KSWZ
}
namespace idx {
typedef unsigned short u16;
typedef short bf16x8 __attribute__((ext_vector_type(8)));
typedef float f32x16 __attribute__((ext_vector_type(16)));
typedef float f32x4 __attribute__((ext_vector_type(4)));
typedef unsigned u32x4 __attribute__((ext_vector_type(4)));
#define IDX_LAS __attribute__((address_space(3)))
constexpr int SEQ = 4096, PITCH = 1024, TOPK = 256;
constexpr int LDS_S = 0, LDS_HIST = 8 * SEQ * 4, LDS_BYTES = LDS_HIST + 8 * 256 * 4;
constexpr float IDX_SCALE = 0.03125f;
__device__ __forceinline__ float bf2f(unsigned h) { return __uint_as_float(h << 16); }

__device__ __forceinline__ void unit(IDX_LAS unsigned char* lds, const u16* QI, const u16* KW, unsigned long long* Mb, int b, int t0) {
    int tid_ = threadIdx.x; asm volatile("" : "+v"(tid_)); const int tid = tid_, wid = __builtin_amdgcn_readfirstlane(tid >> 6), lane = tid & 63, c32 = lane & 31, hi = lane >> 5;
    const int c = t0 >> 6, N = 64 * (c + 1), nt32 = N >> 5, nt = c + 1;
    const size_t rb = (size_t)b * SEQ;
    IDX_LAS float* S = (IDX_LAS float*)(lds + LDS_S);
    bf16x8 af[4][4]; float wv[4][16];
#pragma unroll
    for (int j = 0; j < 4; ++j) {
        const int query = 2 * j + ((c32 >> 2) & 1), head = (c32 & 3) + 4 * (c32 >> 3);
        const u16* qp = QI + (rb + t0 + query) * PITCH + head * 64 + hi * 8;
#pragma unroll
        for (int ks = 0; ks < 4; ++ks) af[j][ks] = *(const bf16x8*)(qp + ks * 16);
        const u16* wp = KW + (rb + t0 + 2 * j + hi) * PITCH + 64;
        const u32x4 w0 = *(const u32x4*)wp, w1 = *(const u32x4*)(wp + 8);
#pragma unroll
        for (int e = 0; e < 4; ++e) { wv[j][2 * e] = bf2f(w0[e] & 0xffffu) * IDX_SCALE; wv[j][2 * e + 1] = __uint_as_float(w0[e] & 0xffff0000u) * IDX_SCALE;
                                      wv[j][8 + 2 * e] = bf2f(w1[e] & 0xffffu) * IDX_SCALE; wv[j][8 + 2 * e + 1] = __uint_as_float(w1[e] & 0xffff0000u) * IDX_SCALE; }
    }
    const u16* kbase = KW + (rb + c32) * PITCH + hi * 8;
    bf16x8 bn[4];
    if (wid < nt32) {
#pragma unroll
        for (int ks = 0; ks < 4; ++ks) bn[ks] = *(const bf16x8*)(kbase + (size_t)(wid * 32) * PITCH + ks * 16);
    }
    for (int kt = wid; kt < nt32; kt += 8) {
        bf16x8 bc[4];
#pragma unroll
        for (int ks = 0; ks < 4; ++ks) bc[ks] = bn[ks];
        if (kt + 8 < nt32) {
#pragma unroll
            for (int ks = 0; ks < 4; ++ks) bn[ks] = *(const bf16x8*)(kbase + (size_t)((kt + 8) * 32) * PITCH + ks * 16);
        }
#pragma unroll
        for (int j = 0; j < 4; ++j) {
            f32x16 acc = {};
#pragma unroll
            for (int ks = 0; ks < 4; ++ks) acc = __builtin_amdgcn_mfma_f32_32x32x16_bf16(af[j][ks], bc[ks], acc, 0, 0, 0);
            float s = 0.f;
#pragma unroll
            for (int r = 0; r < 16; ++r) s = fmaf(wv[j][r], fmaxf(acc[r], 0.f), s);
            S[(2 * j + hi) * SEQ + kt * 32 + c32] = s;
        }
    }
    __syncthreads();
    {
        const IDX_LAS float* row = S + wid * SEQ;
        IDX_LAS unsigned* hist = (IDX_LAS unsigned*)(lds + LDS_HIST) + wid * 256;
        unsigned key[64];
#pragma unroll
        for (int i = 0; i < 64; ++i) {
            unsigned k = 0u;
            if (i < nt) { const unsigned u = __float_as_uint(row[i * 64 + lane]); k = u ^ ((unsigned)((int)u >> 31) | 0x80000000u); }
            key[i] = k;
        }
        unsigned prefix = 0u; int kk = TOPK; unsigned ties = 0u;
#pragma unroll
        for (int pass = 0; pass < 4; ++pass) {
            const int shift = 24 - 8 * pass;
            *(IDX_LAS u32x4*)(hist + lane * 4) = (u32x4){0u, 0u, 0u, 0u};
            asm volatile("s_waitcnt lgkmcnt(0)" ::: "memory");
#pragma unroll
            for (int i = 0; i < 64; ++i) {
                if (i < nt) {
                    const unsigned k = key[i];
                    const bool m = (pass == 0) ? true : ((k >> (shift + 8)) == prefix);
                    if (m) __hip_atomic_fetch_add(hist + ((k >> shift) & 255u), 1u, __ATOMIC_RELAXED, __HIP_MEMORY_SCOPE_WORKGROUP);
                }
            }
            asm volatile("s_waitcnt lgkmcnt(0)" ::: "memory");
            const u32x4 h4 = *(IDX_LAS u32x4*)(hist + lane * 4);
            const unsigned tot = h4[0] + h4[1] + h4[2] + h4[3];
            unsigned v = tot;
#pragma unroll
            for (int o = 1; o < 64; o <<= 1) { const unsigned t = __shfl_down(v, o); if (lane + o < 64) v += t; }
            const unsigned a3 = v - tot, a2 = a3 + h4[3], a1 = a2 + h4[2], a0 = a1 + h4[1];
            const unsigned ukk = (unsigned)kk;
            int myb = -1; unsigned myab = 0u, mycnt = 0u;
            if (a0 < ukk && ukk <= a0 + h4[0]) { myb = 0; myab = a0; mycnt = h4[0]; }
            if (a1 < ukk && ukk <= a1 + h4[1]) { myb = 1; myab = a1; mycnt = h4[1]; }
            if (a2 < ukk && ukk <= a2 + h4[2]) { myb = 2; myab = a2; mycnt = h4[2]; }
            if (a3 < ukk && ukk <= a3 + h4[3]) { myb = 3; myab = a3; mycnt = h4[3]; }
            const unsigned long long bal = __ballot(myb >= 0);
            const int src = (int)__builtin_ctzll(bal);
            const unsigned bin = (unsigned)__shfl(4 * lane + myb, src);
            const unsigned above = (unsigned)__shfl((int)myab, src);
            ties = (unsigned)__shfl((int)mycnt, src);
            prefix = (prefix << 8) | bin; kk -= (int)above;
        }
        const unsigned thr = prefix; const unsigned need = (unsigned)kk;
        const int ntw = 4 * (c >> 2) + 4;
        unsigned mlo = 0u, mhi = 0u;
        if (ties == need) {
#pragma unroll
            for (int i = 0; i < 64; ++i) {
                if (i < nt) { const unsigned long long bal = __ballot(key[i] >= thr);
                    if (lane == i) { mlo = (unsigned)bal; mhi = (unsigned)(bal >> 32); } }
            }
        } else {
            unsigned running = 0u;
#pragma unroll
            for (int i = 0; i < 64; ++i) {
                if (i < nt) { const bool eq = key[i] == thr; const unsigned long long eb = __ballot(eq);
                    const unsigned rank = running + __builtin_amdgcn_mbcnt_hi((unsigned)(eb >> 32), __builtin_amdgcn_mbcnt_lo((unsigned)eb, 0u));
                    const bool sel = (key[i] > thr) || (eq && rank < need);
                    const unsigned long long bal = __ballot(sel);
                    if (lane == i) { mlo = (unsigned)bal; mhi = (unsigned)(bal >> 32); }
                    running += (unsigned)__popcll(eb); }
            }
        }
        if (lane < ntw) Mb[(size_t)lane * SEQ + t0 + wid] = ((unsigned long long)mhi << 32) | mlo;
    }
    __syncthreads();
}
}
#define GAS __attribute__((address_space(1)))
#define LAS __attribute__((address_space(3)))
typedef unsigned short bf16;
typedef unsigned v4u __attribute__((ext_vector_type(4)));
typedef float f32x4 __attribute__((ext_vector_type(4)));
typedef short bf16x8 __attribute__((ext_vector_type(8)));
typedef GAS unsigned gu32;
typedef GAS unsigned long long gu64;
#define RLX_AGENT __ATOMIC_RELAXED, __HIP_MEMORY_SCOPE_AGENT
#define LDS_WAIT() asm volatile("s_waitcnt lgkmcnt(0)" ::: "memory")
#define VM_WAIT() asm volatile("s_waitcnt vmcnt(0)" ::: "memory")
__device__ __forceinline__ unsigned long long rt() { return __builtin_amdgcn_s_memrealtime(); }
__device__ __forceinline__ unsigned f2bf(float f) { unsigned u = __builtin_bit_cast(unsigned, f); return (u + 0x7fffu + ((u >> 16) & 1u)) >> 16; }
__device__ __forceinline__ unsigned pk2(float lo, float hi) { return f2bf(lo) | (f2bf(hi) << 16); }

#define XB_TMO      128
#define XB_XCNT(j)  (256  + 64 * (j))
#define XB_XSUB(j)  (1280 + 64 * (j))
#define XB_XGEN(j)  (2304 + 64 * (j))
#define XB_TOP      3328
#define XB_TOPGEN   3392
#define XCD_BAR_WORDS 3456
#define XB_SPIN_CAP (1u << 18)

__device__ __forceinline__ unsigned xb_ld(unsigned* p)              { return __hip_atomic_load(p, __ATOMIC_RELAXED, __HIP_MEMORY_SCOPE_AGENT); }
__device__ __forceinline__ unsigned xb_add(unsigned* p, unsigned v) { return __hip_atomic_fetch_add(p, v, __ATOMIC_RELAXED, __HIP_MEMORY_SCOPE_AGENT); }
__device__ __forceinline__ unsigned xb_xcc_id() { return (unsigned)__builtin_amdgcn_s_getreg((3 << 11) | 20) & 0xFu; }
#define XB_SPIN(cond, bar) do { unsigned _sp = 0; while (cond) { __builtin_amdgcn_s_sleep(1); \
    if ((++_sp & 255u) == 0u) { if (xb_ld(&(bar)[XB_TMO])) break; if (_sp > XB_SPIN_CAP) { atomicAdd(&(bar)[XB_TMO], 1u); break; } } } } while (0)

struct XcdBarrier {
    unsigned* bar; unsigned x;
    volatile LAS unsigned* st;
};

__device__ __forceinline__ XcdBarrier xcd_barrier_post(unsigned* bar, volatile LAS unsigned* st) {
    XcdBarrier b; b.bar = bar; b.x = xb_xcc_id(); b.st = st;
    if (threadIdx.x == 0) (void)xb_add(&bar[XB_XCNT(b.x)], 1u);
    return b;
}
__device__ __forceinline__ void xcd_barrier_complete(unsigned* bar, unsigned x, unsigned& nloc, unsigned& nx) {
    const unsigned G = gridDim.x * gridDim.y * gridDim.z;
    unsigned sum, cnt, mine, sp = 0u;
    for (;;) {
        sum = 0u; cnt = 0u; mine = 0u;
#pragma unroll
        for (unsigned j = 0; j < 16; ++j) { const unsigned c = xb_ld(&bar[XB_XCNT(j)]); sum += c; cnt += (c > 0u) ? 1u : 0u; mine = (j == x) ? c : mine; }
        if (sum == G) break;
        __builtin_amdgcn_s_sleep(1);
        if ((++sp & 255u) == 0u) { if (xb_ld(&bar[XB_TMO])) break; if (sp > XB_SPIN_CAP) { atomicAdd(&bar[XB_TMO], 1u); break; } }
    }
    nloc = mine > 0u ? mine : 1u; nx = cnt > 0u ? cnt : 1u;
}

__device__ __forceinline__ void xcd_barrier(const XcdBarrier& b) {
    asm volatile("s_waitcnt vmcnt(0)" ::: "memory");
    __syncthreads();
    if (threadIdx.x == 0) {
        unsigned* bar = b.bar;
        __builtin_amdgcn_s_waitcnt(0);
        unsigned nloc = b.st[0], nx = b.st[1];
        if (nloc == 0u) { xcd_barrier_complete(bar, b.x, nloc, nx); b.st[0] = nloc; b.st[1] = nx; }
        const unsigned old = xb_add(&bar[XB_XSUB(b.x)], 1u);
        const unsigned gen = old / nloc;
        if (old + 1u == (gen + 1u) * nloc) {
            __builtin_amdgcn_fence(__ATOMIC_RELEASE, "agent");
            asm volatile("s_waitcnt vmcnt(0)" ::: "memory");
            const unsigned og = xb_add(&bar[XB_TOP], 1u);
            const unsigned tg = og / nx;
            if (og + 1u == (tg + 1u) * nx) xb_add(&bar[XB_TOPGEN], 1u);
            else XB_SPIN(xb_ld(&bar[XB_TOPGEN]) == tg, bar);
            __builtin_amdgcn_fence(__ATOMIC_ACQUIRE, "agent");
            xb_add(&bar[XB_XGEN(b.x)], 1u);
            asm volatile("s_waitcnt vmcnt(0)" ::: "memory");
        } else {
            XB_SPIN(xb_ld(&bar[XB_XGEN(b.x)]) == gen, bar);
            __builtin_amdgcn_fence(__ATOMIC_ACQUIRE, "agent");
            asm volatile("s_waitcnt vmcnt(0)" ::: "memory");
        }
    }
    __syncthreads();
}

constexpr int NWAVES = 8;
constexpr int BATCH = 2, T = 4096, DM = 2048, M = BATCH * T;
constexpr int D_IN = 9296, NPAD = 9472;
constexpr int NTENS = 10, TP = 1024;
constexpr float EPS = 1e-6f;
constexpr float LOG2E = 1.4426950408889634f;
constexpr float C2 = 0.08838834764831845f * 1.4426950408889634f;
constexpr int MAX_REL = 128, NREL = 2 * MAX_REL + 1;

constexpr size_t MiB = 1u << 20;
constexpr size_t WS_CTL = 0, CTL_ZERO_BYTES = 1 * MiB;
constexpr size_t WS_WIN = 1 * MiB;
constexpr size_t WS_WOUT = 38 * MiB;
constexpr size_t WS_XN = 46 * MiB;
constexpr size_t WS_PROJ = 78 * MiB;
constexpr size_t WS_MASK = 238 * MiB;
constexpr size_t WS_PART = 242 * MiB;
constexpr size_t WS_END = 243 * MiB;
constexpr int CW_BAR = 4096;

constexpr int RING_OFF = 0, RING_BYTES = 139264;
constexpr int LDSCTL_OFF = RING_BYTES, MISC_OFF = LDSCTL_OFF + 320;
constexpr int LDS_BYTES = 147456;
static_assert(MISC_OFF + 128 <= LDS_BYTES && idx::LDS_BYTES <= RING_BYTES && att::LDS_BYTES <= RING_BYTES && pg8::STAGE_BYTES <= RING_BYTES, "LDS map");

struct Frame {
    LAS unsigned char* lds;
    volatile LAS unsigned* MISC;
    gu32* ctl;
    int tid, lane, wave;
    int vcu, G;
};

__device__ __forceinline__ float wave_sum(float v) {
#pragma unroll
    for (int o = 1; o < 64; o <<= 1) v += __shfl_xor(v, o);
    return v;
}
__device__ __forceinline__ void p0_transpose_item(const float* W, int K, int N, int NP, bf16* WT, LAS float* scr, int item, int lane) {
    const int nblk = NP / 32, kb = item / nblk, nb = item % nblk, k0 = 64 * kb, n0 = 32 * nb;
    const bool inb = (n0 + (lane & 31)) < N;
#pragma unroll 8
    for (int i = 0; i < 32; ++i) { const int kk = 2 * i + (lane >> 5); scr[kk * 33 + (lane & 31)] = inb ? W[(size_t)(k0 + kk) * N + n0 + (lane & 31)] : 0.f; }
    LDS_WAIT(); asm volatile("" ::: "memory");
    const int c = lane & 7;
#pragma unroll
    for (int j = 0; j < 4; ++j) { const int n = (lane >> 3) + 8 * j; const LAS float* s = scr + (8 * c) * 33 + n;
        v4u o; o.x = pk2(s[0 * 33], s[1 * 33]); o.y = pk2(s[2 * 33], s[3 * 33]); o.z = pk2(s[4 * 33], s[5 * 33]); o.w = pk2(s[6 * 33], s[7 * 33]);
        *(GAS v4u*)(WT + (size_t)(n0 + n) * K + k0 + 8 * c) = o; }
    LDS_WAIT(); asm volatile("" ::: "memory");
}
__device__ __forceinline__ void rms_row_to_bf16(int lane, const float* xrow, const float* gain, bf16* orow) {
    const GAS f32x4* xr = (const GAS f32x4*)xrow + lane; const GAS f32x4* gr = (const GAS f32x4*)gain + lane;
    f32x4 v[8]; float s = 0.f;
#pragma unroll
    for (int j = 0; j < 8; ++j) { v[j] = xr[64 * j]; s += (v[j].x * v[j].x + v[j].y * v[j].y) + (v[j].z * v[j].z + v[j].w * v[j].w); }
    const float rstd = 1.f / sqrtf(wave_sum(s) * (1.f / DM) + EPS);
    GAS unsigned long long* o8 = (GAS unsigned long long*)orow + lane;
#pragma unroll
    for (int j = 0; j < 8; ++j) { const f32x4 g = gr[64 * j];
        o8[64 * j] = (unsigned long long)pk2(v[j].x * rstd * g.x, v[j].y * rstd * g.y) | ((unsigned long long)pk2(v[j].z * rstd * g.z, v[j].w * rstd * g.w) << 32); }
}

struct Args { const float* x; const float* norm_gain; const float* w_in; const float* rel_bias; const float* w_out; const float* final_gain; float* out; unsigned char* ws; };
__global__ void __launch_bounds__(NWAVES * 64, 2) skel_fwd(Args args) {
    extern __shared__ __attribute__((aligned(16))) unsigned char lds[];
    Frame F;
    F.lds = (LAS unsigned char*)lds;
    F.MISC = (volatile LAS unsigned*)(F.lds + MISC_OFF);
    F.tid = threadIdx.x; F.lane = F.tid & 63; F.wave = __builtin_amdgcn_readfirstlane(F.tid >> 6);
    F.G = gridDim.x; { const int bx = blockIdx.x; F.vcu = (F.G % 8 == 0) ? (bx % 8) * (F.G / 8) + bx / 8 : bx; }
    unsigned char* ws = args.ws;
    F.ctl = (gu32*)(ws + WS_CTL);
    bf16* Win_t = (bf16*)(ws + WS_WIN); bf16* Wout_t = (bf16*)(ws + WS_WOUT); bf16* XN = (bf16*)(ws + WS_XN); bf16* Y = XN;
    bf16* PROJ = (bf16*)(ws + WS_PROJ); unsigned long long* MASK = (unsigned long long*)(ws + WS_MASK); float* PART = (float*)(ws + WS_PART);
    for (int u = F.tid; u < (LDS_BYTES - LDSCTL_OFF) / 4; u += NWAVES * 64) ((LAS unsigned*)(F.lds + LDSCTL_OFF))[u] = 0u;
    __syncthreads();
    XcdBarrier bar = xcd_barrier_post((unsigned*)(F.ctl + CW_BAR), F.MISC + 8);
    const int gw = F.vcu * NWAVES + F.wave, NGW = F.G * NWAVES;

    {
        LAS float* scr = (LAS float*)(F.lds + RING_OFF + F.wave * 16384);
        constexpr int I_IN = (DM / 64) * (NPAD / 32), I_OUT = (DM / 64) * (DM / 32);
        for (int it = gw; it < I_IN + I_OUT; it += NGW) {
            if (it < I_IN) p0_transpose_item(args.w_in, DM, D_IN, NPAD, Win_t, scr, it, F.lane);
            else p0_transpose_item(args.w_out, DM, DM, DM, Wout_t, scr, it - I_IN, F.lane);
        }
        for (int m = gw; m < M; m += NGW) rms_row_to_bf16(F.lane, args.x + (size_t)m * DM, args.norm_gain, XN + (size_t)m * DM);
        for (int e = blockIdx.x * (NWAVES * 64) + F.tid; e < BATCH * 4 * 256; e += F.G * NWAVES * 64) {
            const int b = e / 1024, jt = (e >> 8) & 3, t = e & 255;
            MASK[((size_t)b * 64 + jt) * T + t] = (jt <= (t >> 6)) ? ~0ull : 0ull;
        }
    }
    xcd_barrier(bar);

    {
        pg8::Gemm g{XN, Win_t, M, NPAD, DM}; pg8::StaticOrder S; S.init(M, NPAD, F.G, (int)blockIdx.x);
        pg8::EpiSplit E{PROJ, TP, TP, (size_t)M * TP, C2};
        pg8::gemm_phase<pg8::EpiSplit, pg8::StaticOrder, true, true>(F.lds + RING_OFF, g, S, E);
    }
    xcd_barrier(bar);

    {
        const size_t TS = (size_t)M * TP;
        for (int a = F.vcu; a < 256; a += F.G) {
            const int bh = a >> 4, qb = a & 15, b = bh >> 3, h = bh & 7;
            float* bt = (float*)((char*)lds + RING_OFF + att::LDS_BT);
            for (int i = F.tid; i < NREL; i += NWAVES * 64) bt[i] = args.rel_bias[h * NREL + i] * LOG2E;
            const size_t ro = (size_t)b * T * TP + (size_t)h * 128;
            att::BlockRef cur{PROJ + 0 * TS + ro, PROJ + 1 * TS + ro, PROJ + 2 * TS + ro, PROJ + 3 * TS + ro, Y + (size_t)b * T * DM + h * 128, nullptr, qb * 256, 0.f};
            att::Seam S;
            att::attn_prime<0>(cur, (char*)lds + RING_OFF, S);
            att::attn_block<0>(cur, cur, (char*)lds + RING_OFF, S);
        }
        __syncthreads();
        for (int cu = (int)blockIdx.x; cu < 256; cu += F.G)
            for (int rnd = 0; rnd < 4; ++rnd) {
                const int u = (rnd & 1) ? (rnd * 256 + 255 - cu) : (rnd * 256 + cu);
                if (u >= 960) continue;
                const int c = 63 - (u >> 4), b = (u >> 3) & 1, t0 = c * 64 + (u & 7) * 8;
                idx::unit(F.lds + RING_OFF, PROJ + 8 * TS, PROJ + 9 * TS, MASK + (size_t)b * 64 * T, b, t0);
            }
    }
    xcd_barrier(bar);

    {
        const size_t TS = (size_t)M * TP;
        for (int a = F.vcu; a < 256; a += F.G) {
            const int bh = a >> 4, qb = 15 - (a & 15), b = bh >> 3, h = bh & 7;
            const size_t ro = (size_t)b * T * TP + (size_t)h * 128;
            const float slope = __builtin_amdgcn_exp2f(-(float)(h + 1));
            att::BlockRef cur{PROJ + 4 * TS + ro, PROJ + 5 * TS + ro, PROJ + 6 * TS + ro, PROJ + 7 * TS + ro, Y + (size_t)b * T * DM + 1024 + h * 128,
                              MASK + (size_t)b * 64 * T, qb * 256, -slope * LOG2E};
            att::Seam S;
            att::attn_prime<1>(cur, (char*)lds + RING_OFF, S);
            att::attn_block<1>(cur, cur, (char*)lds + RING_OFF, S);
        }
    }
    xcd_barrier(bar);

    {
        pg8::Gemm g{Y, Wout_t, M, DM, DM}; pg8::StaticOrder S; S.init(M, DM, F.G, (int)blockIdx.x);
        pg8::EpiResid E{args.x, args.out, PART, DM};
        pg8::gemm_phase<pg8::EpiResid, pg8::StaticOrder, true, true>(F.lds + RING_OFF, g, S, E);
    }
    xcd_barrier(bar);

    for (int m = gw; m < M; m += NGW) {
        float s = (F.lane < 32) ? PART[(size_t)m * 32 + F.lane] : 0.f;
        s = wave_sum(s);
        const float rstd = 1.f / sqrtf(s * (1.f / DM) + EPS);
        GAS f32x4* xr = (GAS f32x4*)(args.out + (size_t)m * DM) + F.lane; const GAS f32x4* gr = (const GAS f32x4*)args.final_gain + F.lane;
#pragma unroll
        for (int j = 0; j < 8; ++j) { const f32x4 v = xr[64 * j], g = gr[64 * j]; xr[64 * j] = (f32x4){v.x * rstd * g.x, v.y * rstd * g.y, v.z * rstd * g.z, v.w * rstd * g.w}; }
    }
}

extern "C" void kernel_launch(void* const* d_in, const int* in_sizes, int n_in, void* d_out, int out_size, void* d_ws, size_t ws_size, hipStream_t stream) {
    static int grid = 0;
    if (grid == 0) {
        if (n_in != 6 || in_sizes[0] != M * DM || in_sizes[2] != DM * D_IN || out_size != M * DM || ws_size < WS_END) {
            fprintf(stderr, "kernel_launch: unexpected shapes / workspace (n_in %d, ws %zu); nothing launched\n", n_in, ws_size); grid = -1; return; }
        int dev = 0, cus = 0;
        if (hipGetDevice(&dev) != hipSuccess || hipDeviceGetAttribute(&cus, hipDeviceAttributeMultiprocessorCount, dev) != hipSuccess) { grid = -1; return; }
        if (hipFuncSetAttribute((const void*)skel_fwd, hipFuncAttributeMaxDynamicSharedMemorySize, LDS_BYTES) != hipSuccess) { fprintf(stderr, "kernel_launch: hipFuncSetAttribute failed\n"); grid = -1; return; }
        (void)hipGetLastError();
        grid = cus < 256 ? cus : 256;
    }
    if (grid < 0) return;
    if (hipMemsetAsync((char*)d_ws + WS_CTL, 0, CTL_ZERO_BYTES, stream) != hipSuccess) return;
    Args a{};
    a.x = (const float*)d_in[0]; a.norm_gain = (const float*)d_in[1]; a.w_in = (const float*)d_in[2]; a.rel_bias = (const float*)d_in[3];
    a.w_out = (const float*)d_in[4]; a.final_gain = (const float*)d_in[5]; a.out = (float*)d_out; a.ws = (unsigned char*)d_ws;
    hipLaunchKernelGGL(skel_fwd, dim3(grid), dim3(NWAVES * 64), LDS_BYTES, stream, a);
}
```

```cpp
#include <hip/hip_runtime.h>
#include <hip/hip_bf16.h>
#include <cstdio>
#include <cstdint>
namespace pg8 {
#define PG8_LAS __attribute__((address_space(3)))
typedef unsigned short bf16_t;
typedef short bf16x8 __attribute__((ext_vector_type(8)));
typedef float f32x4 __attribute__((ext_vector_type(4)));
typedef unsigned u32x4 __attribute__((ext_vector_type(4)));
typedef int i32x4 __attribute__((ext_vector_type(4)));
typedef int i32x8 __attribute__((ext_vector_type(8)));
constexpr int BM = 256, BK = 64, HALF = 128, HTB = HALF * BK * 2  , STAGE_BYTES = 8 * HTB, NXCD = 8, WGM = 8;

__host__ __device__ __forceinline__ int lds_byte(int r, int c) { const int st = (r >> 4) * 2 + (c >> 5), rr = r & 15, cc = c & 31, ob = rr * 64 + cc * 2; return st * 1024 + (ob ^ (((ob >> 9) & 1) << 5)); }
__host__ __device__ __forceinline__ void stage_rc(int b, int& R, int& C) { const int st = b / 1024, sb = b % 1024, swz = sb ^ (((sb >> 9) & 1) << 5); R = (st >> 1) * 16 + swz / 64; C = (st & 1) * 32 + (swz % 64) / 2; }
__host__ __device__ __forceinline__ int perm32(int rho) { const int n = rho >> 4, i = rho & 15; return 8 * (i >> 2) + 4 * n + (i & 3); }

struct Unit { int pm, pn; };
struct Gemm { const bf16_t* A; const bf16_t* Bt; int M, N, K; };

struct StaticOrder {
    int nM, nN, nwg, G, c;
    __host__ __device__ void init(int M, int N, int G_, int c_) { nM = M / BM; nN = N / BM; nwg = nM * nN; G = G_; c = c_; }
    __host__ __device__ bool next(int i, Unit& u) const {
        const long L = (long)i * G + c; if (L >= nwg) return false;
        int wgid = (int)L; { const int q = nwg / NXCD, r = nwg % NXCD, xcd = wgid % NXCD, off = wgid / NXCD; wgid = (xcd < r ? xcd * (q + 1) : r * (q + 1) + (xcd - r) * q) + off; }
        const int nig = WGM * nN, gid = wgid / nig, fm = gid * WGM, gsz = (nM - fm) < WGM ? (nM - fm) : WGM;
        u.pm = fm + ((wgid % nig) % gsz); u.pn = (wgid % nig) / gsz; return true;
    }
    __device__ __forceinline__ void a_ready(const Unit&) const {}
    __device__ __forceinline__ void done(const Unit&) const {}
};

__device__ __forceinline__ unsigned cvt_pk_bf16(float lo, float hi) { unsigned r; asm volatile("v_cvt_pk_bf16_f32 %0, %1, %2" : "=v"(r) : "v"(lo), "v"(hi)); return r; }

struct EpiSplit {
    static constexpr bool PERM = true, AFTER_DRAIN = false;
    bf16_t* O; int ldc; int split_cols; size_t split_stride; float scale0; float scale; int col_base;
    __device__ __forceinline__ void operator()(const f32x4 (&acc)[2][2][4][2], const Unit& u, int wr, int wc, int fr, int fq) const {
        const int row0 = u.pm * BM + wr * 64 + fr; int colt = u.pn * BM + col_base; bf16_t* base = O;
        float sc = scale; { const int t = colt / split_cols; base += (size_t)t * split_stride; colt -= t * split_cols; if (t == 0 || t == 4) sc *= scale0; }
        const int col0 = colt + wc * 32 + 8 * fq;
#pragma unroll
        for (int ai = 0; ai < 2; ++ai)
#pragma unroll
            for (int m = 0; m < 4; ++m) { bf16_t* rowp = base + (size_t)(row0 + ai * HALF + m * 16) * ldc + col0;
#pragma unroll
                for (int bj = 0; bj < 2; ++bj) { f32x4 v0 = acc[ai][bj][m][0] * sc, v1 = acc[ai][bj][m][1] * sc;
                    u32x4 w; w.x = cvt_pk_bf16(v0[0], v0[1]); w.y = cvt_pk_bf16(v0[2], v0[3]); w.z = cvt_pk_bf16(v1[0], v1[1]); w.w = cvt_pk_bf16(v1[2], v1[3]);
                    *(u32x4*)(rowp + bj * HALF) = w; } }
    }
};
struct EpiResid {
    static constexpr bool PERM = false, AFTER_DRAIN = false;
    const float* base; float* out; float* part; int ldc; float scale;
    __device__ __forceinline__ void operator()(const f32x4 (&acc)[2][2][4][2], const Unit& u, int wr, int wc, int fr, int fq) const {
        const int col0 = u.pn * BM + wc * 32 + 4 * fq;
#pragma unroll
        for (int ai = 0; ai < 2; ++ai)
#pragma unroll
            for (int m = 0; m < 4; ++m) { const int r = u.pm * BM + ai * HALF + wr * 64 + m * 16 + fr; const size_t off = (size_t)r * ldc + col0; float ss = 0.f;
#pragma unroll
                for (int bj = 0; bj < 2; ++bj)
#pragma unroll
                    for (int n = 0; n < 2; ++n) { const f32x4 bs = *(const f32x4*)(base + off + bj * HALF + n * 16); const f32x4 o = bs + acc[ai][bj][m][n] * scale;
                        *(f32x4*)(out + off + bj * HALF + n * 16) = o; ss += (o[0] * o[0] + o[1] * o[1]) + (o[2] * o[2] + o[3] * o[3]); }
                ss += __shfl_xor(ss, 16); ss += __shfl_xor(ss, 32);
                if (fq == 0) part[(size_t)r * 32 + u.pn * 4 + wc] = ss; }
    }
};

template <class Epi, class Sched, bool ALIGN_EPI = false, bool SP2 = false, bool FP8 = false>
__device__ __forceinline__ void gemm_phase(PG8_LAS unsigned char* lds, const Gemm g, const Sched& S, const Epi& E, int wave_) {
    int tid_; asm volatile("v_mbcnt_lo_u32_b32 %0, -1, 0\n\tv_mbcnt_hi_u32_b32 %0, -1, %0\n\tv_lshl_add_u32 %0, %1, 6, %0" : "=&v"(tid_) : "s"(wave_)); const int tid = tid_, wid = __builtin_amdgcn_readfirstlane(tid >> 6), lane = tid & 63, wr = wid >> 2, wc = wid & 3, fr = lane & 15, fq = lane >> 4;
    const int K = g.K, nt = K / BK;
    unsigned voffA[2], voffB[2];
#pragma unroll
    for (int i = 0; i < 2; ++i) { int R, C; stage_rc(tid * 16 + i * 8192, R, C); const int Rb = Epi::PERM ? ((R & ~31) + perm32(R & 31)) : R;
        voffA[i] = (unsigned)(R * K + C) * 2u; voffB[i] = (unsigned)(Rb * K + C) * 2u; }
    const size_t kstep = (size_t)(BK * 2);
    const size_t hstep = (size_t)HALF * K * 2;
    const size_t tstep = 2 * hstep;
    const unsigned ldsw = (unsigned)wid * 1024u;
    const int aoff = lds_byte(wr * 64 + fr, fq * 8), boff = lds_byte(wc * 32 + fr, fq * 8);
#define PG8_SA(b, h) (((b) * 2 + (h)) * HTB)
#define PG8_SB(b, h) ((4 + (b) * 2 + (h)) * HTB)
#define PG8_STAGE(bufoff, gbase, voff) do { _Pragma("unroll") for (int _i = 0; _i < 2; ++_i) \
        __builtin_amdgcn_global_load_lds((const unsigned*)((const char*)(gbase) + (voff)[_i]), (PG8_LAS unsigned*)(lds + (bufoff) + ldsw + _i * 8192), 16, 0, 0); } while (0)
#define PG8_LDA(dst, b, h) do { _Pragma("unroll") for (int m = 0; m < 4; ++m) _Pragma("unroll") for (int k = 0; k < 2; ++k) dst[m][k] = *(const PG8_LAS bf16x8*)(lds + PG8_SA(b, h) + aoff + m * 2048 + k * 1024); } while (0)
#define PG8_LDB(dst, b, h) do { _Pragma("unroll") for (int n = 0; n < 2; ++n) _Pragma("unroll") for (int k = 0; k < 2; ++k) dst[n][k] = *(const PG8_LAS bf16x8*)(lds + PG8_SB(b, h) + boff + n * 2048 + k * 1024); } while (0)
#define PG8_MMA(ai, bj, At, Bt) do { __builtin_amdgcn_s_setprio(1); _Pragma("unroll") for (int m = 0; m < 4; ++m) _Pragma("unroll") for (int n = 0; n < 2; ++n) { \
        if constexpr (FP8) {   \
            const i32x8 b8_ = __builtin_shufflevector(__builtin_bit_cast(i32x4, Bt[n][0]), __builtin_bit_cast(i32x4, Bt[n][1]), 0, 1, 2, 3, 4, 5, 6, 7); \
            const i32x8 a8_ = __builtin_shufflevector(__builtin_bit_cast(i32x4, At[m][0]), __builtin_bit_cast(i32x4, At[m][1]), 0, 1, 2, 3, 4, 5, 6, 7); \
            asm volatile("v_mfma_f32_16x16x128_f8f6f4 %0, %1, %2, %0" : "+v"(acc[ai][bj][m][n]) : "v"(b8_), "v"(a8_));   \
        } else { _Pragma("unroll") for (int k = 0; k < 2; ++k) \
            acc[ai][bj][m][n] = __builtin_amdgcn_mfma_f32_16x16x32_bf16(Bt[n][k], At[m][k], acc[ai][bj][m][n], 0, 0, 0); } } __builtin_amdgcn_s_setprio(0); } while (0)
#define PG8_WAIT_V(n) asm volatile("s_waitcnt vmcnt(" #n ")" ::: "memory")
#define PG8_WAIT_L(n) asm volatile("s_waitcnt lgkmcnt(" #n ")" ::: "memory")
#define PG8_BAR __builtin_amdgcn_s_barrier()
#define PG8_SCHED __builtin_amdgcn_sched_barrier(0)
    Unit cur, nxt; int ui = 0;
    if (!S.next(0, cur)) return;
    f32x4 acc[2][2][4][2];
#pragma unroll
    for (int a = 0; a < 2; ++a)
#pragma unroll
        for (int b = 0; b < 2; ++b)
#pragma unroll
            for (int m = 0; m < 4; ++m)
#pragma unroll
                for (int n = 0; n < 2; ++n) acc[a][b][m][n] = (f32x4){0.f, 0.f, 0.f, 0.f};
    bf16x8 At[4][2], B0[2][2], B1[2][2];
    const char* cA = (const char*)g.A + (size_t)cur.pm * tstep; const char* cB = (const char*)g.Bt + (size_t)cur.pn * tstep;
    S.a_ready(cur);
    if constexpr (SP2) {
        PG8_STAGE(PG8_SB(0, 0), cB, voffB); PG8_STAGE(PG8_SB(0, 1), cB + hstep, voffB); PG8_STAGE(PG8_SA(0, 0), cA, voffA); PG8_STAGE(PG8_SA(0, 1), cA + hstep, voffA);
        if (wr == 1) PG8_BAR;
        PG8_WAIT_V(2); PG8_BAR;
        PG8_STAGE(PG8_SB(1, 0), cB + kstep, voffB); PG8_STAGE(PG8_SA(1, 0), cA + kstep, voffA); PG8_STAGE(PG8_SB(1, 1), cB + hstep + kstep, voffB);
        PG8_WAIT_V(6); PG8_BAR;
    } else {
        PG8_STAGE(PG8_SB(0, 0), cB, voffB); PG8_STAGE(PG8_SA(0, 0), cA, voffA); PG8_STAGE(PG8_SB(0, 1), cB + hstep, voffB); PG8_STAGE(PG8_SA(0, 1), cA + hstep, voffA);
        if (wr == 1) PG8_BAR;
        PG8_WAIT_V(4); PG8_BAR;
        PG8_STAGE(PG8_SB(1, 0), cB + kstep, voffB); PG8_STAGE(PG8_SA(1, 0), cA + kstep, voffA); PG8_STAGE(PG8_SB(1, 1), cB + hstep + kstep, voffB);
        PG8_WAIT_V(6); PG8_BAR;
    }
    for (;;) {
        const bool has_next = S.next(ui + 1, nxt);
        const char* nA = has_next ? (const char*)g.A + (size_t)nxt.pm * tstep : cA; const char* nB = has_next ? (const char*)g.Bt + (size_t)nxt.pn * tstep : cB;
        for (int t = 0; t < nt; t += 2) {
            const bool last = (t == nt - 2);
            const char* a1 = cA + (size_t)(t + 1) * kstep;
            const char* a2 = last ? nA : cA + (size_t)(t + 2) * kstep; const char* b2 = last ? nB : cB + (size_t)(t + 2) * kstep;
            const char* a3 = a2 + kstep; const char* b3 = b2 + kstep;
            if (last && has_next) S.a_ready(nxt);
            if constexpr (SP2) {
            PG8_LDB(B0, 0, 0); PG8_LDB(B1, 0, 1); PG8_SCHED; PG8_LDA(At, 0, 0); PG8_STAGE(PG8_SA(1, 1), a1 + hstep, voffA);
            PG8_WAIT_V(8); PG8_WAIT_L(0); PG8_BAR; PG8_MMA(0, 0, At, B0); PG8_MMA(0, 1, At, B1); PG8_BAR; PG8_SCHED;
            PG8_LDA(At, 0, 1); PG8_STAGE(PG8_SB(0, 0), b2, voffB); PG8_STAGE(PG8_SB(0, 1), b2 + hstep, voffB); PG8_STAGE(PG8_SA(0, 0), a2, voffA);
            PG8_WAIT_V(8); PG8_WAIT_L(0); PG8_BAR; PG8_MMA(1, 0, At, B0); PG8_MMA(1, 1, At, B1); PG8_BAR; PG8_SCHED;
            PG8_LDB(B0, 1, 0); PG8_LDB(B1, 1, 1); PG8_SCHED; PG8_LDA(At, 1, 0); PG8_STAGE(PG8_SA(0, 1), a2 + hstep, voffA);
            PG8_WAIT_V(8); PG8_WAIT_L(0); PG8_BAR; PG8_MMA(0, 0, At, B0); PG8_MMA(0, 1, At, B1); PG8_BAR; PG8_SCHED;
            PG8_LDA(At, 1, 1); PG8_STAGE(PG8_SB(1, 0), b3, voffB); PG8_STAGE(PG8_SB(1, 1), b3 + hstep, voffB); PG8_STAGE(PG8_SA(1, 0), a3, voffA);
            PG8_WAIT_V(8); PG8_WAIT_L(0); PG8_BAR; PG8_MMA(1, 0, At, B0); PG8_MMA(1, 1, At, B1); PG8_BAR; PG8_SCHED;
            } else {
            PG8_LDB(B0, 0, 0); PG8_SCHED; PG8_LDA(At, 0, 0); PG8_STAGE(PG8_SA(1, 1), a1 + hstep, voffA);
            PG8_WAIT_L(8); PG8_BAR; PG8_WAIT_L(0); PG8_MMA(0, 0, At, B0); PG8_BAR; PG8_SCHED;
            PG8_LDB(B1, 0, 1); PG8_STAGE(PG8_SB(0, 0), b2, voffB);
            PG8_BAR; PG8_WAIT_L(0); PG8_MMA(0, 1, At, B1); PG8_BAR;
            PG8_LDA(At, 0, 1); PG8_STAGE(PG8_SA(0, 0), a2, voffA);
            PG8_BAR; PG8_WAIT_L(0); PG8_MMA(1, 0, At, B0); PG8_BAR; PG8_SCHED;
            PG8_STAGE(PG8_SB(0, 1), b2 + hstep, voffB);
            PG8_WAIT_V(6); PG8_BAR; PG8_MMA(1, 1, At, B1); PG8_BAR;
            PG8_LDB(B0, 1, 0); PG8_SCHED; PG8_LDA(At, 1, 0); PG8_STAGE(PG8_SA(0, 1), a2 + hstep, voffA);
            PG8_WAIT_L(8); PG8_BAR; PG8_WAIT_L(0); PG8_MMA(0, 0, At, B0); PG8_BAR; PG8_SCHED;
            PG8_LDB(B1, 1, 1); PG8_STAGE(PG8_SB(1, 0), b3, voffB);
            PG8_BAR; PG8_WAIT_L(0); PG8_MMA(0, 1, At, B1); PG8_BAR;
            PG8_LDA(At, 1, 1); PG8_STAGE(PG8_SA(1, 0), a3, voffA);
            PG8_BAR; PG8_WAIT_L(0); PG8_MMA(1, 0, At, B0); PG8_BAR; PG8_SCHED;
            PG8_STAGE(PG8_SB(1, 1), b3 + hstep, voffB);
            PG8_WAIT_V(6); PG8_BAR; PG8_MMA(1, 1, At, B1); PG8_BAR;
            }
        }
        if constexpr (ALIGN_EPI) { if (wr == 0) PG8_BAR; }
        if constexpr (FP8) asm volatile("s_nop 15\n\ts_nop 15" ::: "memory");
        if constexpr (!Epi::AFTER_DRAIN) { E(acc, cur, wr, wc, fr, fq); S.done(cur); }
        if (!has_next) break;
#pragma unroll
        for (int a = 0; a < 2; ++a)
#pragma unroll
            for (int b = 0; b < 2; ++b)
#pragma unroll
                for (int m = 0; m < 4; ++m)
#pragma unroll
                    for (int n = 0; n < 2; ++n) acc[a][b][m][n] = (f32x4){0.f, 0.f, 0.f, 0.f};
        cur = nxt; cA = nA; cB = nB; ++ui;
        if constexpr (ALIGN_EPI) { if (wr == 1) PG8_BAR; }
    }
    PG8_WAIT_V(0);
    if constexpr (!ALIGN_EPI) { if (wr == 0) PG8_BAR; }
    PG8_BAR;
    if constexpr (Epi::AFTER_DRAIN) { E.fused(acc, cur, wr, wc, fr, fq, lds, wid, lane); S.done(cur); }
#undef PG8_SA
#undef PG8_SB
#undef PG8_STAGE
#undef PG8_LDA
#undef PG8_LDB
#undef PG8_MMA
#undef PG8_WAIT_V
#undef PG8_WAIT_L
#undef PG8_BAR
#undef PG8_SCHED
}
}
namespace att {
typedef unsigned short u16;
typedef short bf16x8 __attribute__((ext_vector_type(8)));
typedef short s16x4 __attribute__((ext_vector_type(4)));
typedef float f32x16 __attribute__((ext_vector_type(16)));
typedef float f32x4 __attribute__((ext_vector_type(4)));
typedef unsigned u32x4 __attribute__((ext_vector_type(4)));
typedef unsigned u32x2 __attribute__((ext_vector_type(2)));
constexpr int D = 128, NW = 8, QBLK = 32, KVBLK = 64, QB = NW * QBLK;
constexpr int PITCH = 1024;
constexpr int YPITCH = 2048;
constexpr float Y8_SCALE = 16.f;
constexpr int SEQ = 4096;
constexpr int SHM_V = KVBLK * D * 2, SHM_K = KVBLK * D * 2;
constexpr int LDS_WS = 2 * SHM_V + 2 * SHM_K;
constexpr int LDS_BT = LDS_WS + NW * 64 * 4;
constexpr int LDS_MT = LDS_BT + 1280;
constexpr int LDS_BYTES = LDS_MT + NW * 96 * 4;
constexpr float THR = 8.f;

#define KSWZ(row, colB) ((row) * 256 + ((colB) ^ (((row) & 7) << 4)))
#define SBAR() __builtin_amdgcn_sched_barrier(0)
__device__ __forceinline__ int v_st(int k, int c) { const int kk = (k & ~0xC) | ((k & 4) << 1) | ((k & 8) >> 1); return ((kk >> 3) * 4 + (c >> 5)) * 512 + ((kk & 7) * 32 + (c & 31)) * 2; }
__device__ __forceinline__ int v_rd_base(int lane) { return ((lane & 3) << 3) | (((lane >> 2) & 3) << 6) | (((lane >> 4) & 1) << 5) | (((lane >> 5) & 1) << 8); }
constexpr int v_rd_off(int d0, int ks, int half) { return d0 * 512 + ks * 4096 + half * 2048; }
__device__ __forceinline__ int crow(int r, int hi) { return (r & 3) + 8 * (r >> 2) + 4 * hi; }
__device__ __forceinline__ unsigned cvtpk(float lo, float hi) { unsigned r; asm volatile("v_cvt_pk_bf16_f32 %0, %1, %2" : "=v"(r) : "v"(lo), "v"(hi)); return r; }
__device__ __forceinline__ bf16x8 load8(const u16* p) { return *reinterpret_cast<const bf16x8*>(p); }
__device__ __forceinline__ float bf2f(unsigned h) { return __uint_as_float(h << 16); }

__device__ __forceinline__ void partialSM(f32x16& p0, f32x16& p1, float& m_reg, float& alpha) {
    float pmax = p0[0];
#pragma unroll
    for (int r = 1; r < 16; ++r) pmax = fmaxf(pmax, p0[r]);
#pragma unroll
    for (int r = 0; r < 16; ++r) pmax = fmaxf(pmax, p1[r]);
    { auto rr = __builtin_amdgcn_permlane32_swap(__float_as_uint(pmax), __float_as_uint(pmax), false, false);
      pmax = fmaxf(__uint_as_float(rr[0]), __uint_as_float(rr[1])); }
    float mn;
    if (__builtin_expect(__all((pmax - m_reg) <= THR), 1)) { mn = m_reg; alpha = 1.f; }
    else { mn = fmaxf(m_reg, pmax); alpha = __builtin_amdgcn_exp2f(m_reg - mn); m_reg = mn; }
#pragma unroll
    for (int r = 0; r < 16; ++r) p0[r] = p0[r] - mn;
#pragma unroll
    for (int r = 0; r < 16; ++r) p1[r] = p1[r] - mn;
#pragma unroll
    for (int r = 0; r < 16; ++r) p0[r] = __builtin_amdgcn_exp2f(p0[r]);
}
__device__ __forceinline__ void finishSM(f32x16& p0, f32x16& p1, float alpha, float& l_reg, bf16x8& pa0, bf16x8& pa1, bf16x8& pa2, bf16x8& pa3) {
#pragma unroll
    for (int r = 0; r < 16; ++r) p1[r] = __builtin_amdgcn_exp2f(p1[r]);
    float ps = 0;
#pragma unroll
    for (int r = 0; r < 16; ++r) ps += p0[r];
#pragma unroll
    for (int r = 0; r < 16; ++r) ps += p1[r];
    { auto rr = __builtin_amdgcn_permlane32_swap(__float_as_uint(ps), __float_as_uint(ps), false, false);
      ps = __uint_as_float(rr[0]) + __uint_as_float(rr[1]); }
    l_reg = l_reg * alpha + ps;
#define PK4(P, B_, OUT) do { unsigned a0 = cvtpk(P[B_+0], P[B_+1]), a1 = cvtpk(P[B_+2], P[B_+3]);                          \
        unsigned b0 = cvtpk(P[B_+4], P[B_+5]), b1 = cvtpk(P[B_+6], P[B_+7]);                                             \
        auto r0 = __builtin_amdgcn_permlane32_swap(a0, b0, false, false); auto r1 = __builtin_amdgcn_permlane32_swap(a1, b1, false, false); \
        u32x4 w = {r0[0], r1[0], r0[1], r1[1]}; OUT = *reinterpret_cast<bf16x8*>(&w); } while (0)
    PK4(p0, 0, pa0); PK4(p0, 8, pa1); PK4(p1, 0, pa2); PK4(p1, 8, pa3);
#undef PK4
}
template <int KB>
__device__ __forceinline__ void qkt(f32x16& p0, f32x16& p1, const char* K_lds, int r32, int hi, const bf16x8* qr, bool act) {
    if (!act) { const float NEG = -__builtin_inff();
#pragma unroll
        for (int r = 0; r < 16; ++r) { p0[r] = NEG; p1[r] = NEG; } return; }
    p0 = f32x16{}; p1 = f32x16{};
    const char* kb[4];
#pragma unroll
    for (int dd = 0; dd < 4; ++dd) kb[dd] = K_lds + KB * SHM_K + KSWZ(r32, (dd * 16 + hi * 8) * 2);
#pragma unroll
    for (int d0 = 0; d0 < 8; ++d0) { const char* a = kb[d0 & 3] + (d0 >> 2) * 128;
        bf16x8 b0 = *reinterpret_cast<const bf16x8*>(a);
        bf16x8 b1 = *reinterpret_cast<const bf16x8*>(a + 32 * 256);
        p0 = __builtin_amdgcn_mfma_f32_32x32x16_bf16(b0, qr[d0], p0, 0, 0, 0);
        p1 = __builtin_amdgcn_mfma_f32_32x32x16_bf16(b1, qr[d0], p1, 0, 0, 0); }
}
template <int VB>
__device__ __forceinline__ void pv_tile(f32x16* o, int vb0, bf16x8 pa0, bf16x8 pa1, bf16x8 pa2, bf16x8 pa3, bool act) {
    if (!act) return;
#define TRRD(dst, off) asm volatile("ds_read_b64_tr_b16 %0, %1 offset:%2" : "=&v"(dst) : "v"(vb0), "i"(off) : "memory")
#define PV_D0(d0) do { s16x4 l0, l1, l2, l3, h0, h1, h2, h3; constexpr int b_ = VB * SHM_V + v_rd_off(d0, 0, 0); \
        TRRD(l0, b_); TRRD(h0, b_ + 2048); TRRD(l1, b_ + 4096); TRRD(h1, b_ + 6144); TRRD(l2, b_ + 8192); TRRD(h2, b_ + 10240); TRRD(l3, b_ + 12288); TRRD(h3, b_ + 14336); \
        asm volatile("s_waitcnt lgkmcnt(0)" ::: "memory"); SBAR(); \
        o[d0] = __builtin_amdgcn_mfma_f32_32x32x16_bf16(pa0, (bf16x8){l0[0], l0[1], l0[2], l0[3], h0[0], h0[1], h0[2], h0[3]}, o[d0], 0, 0, 0);   \
        o[d0] = __builtin_amdgcn_mfma_f32_32x32x16_bf16(pa1, (bf16x8){l1[0], l1[1], l1[2], l1[3], h1[0], h1[1], h1[2], h1[3]}, o[d0], 0, 0, 0);   \
        o[d0] = __builtin_amdgcn_mfma_f32_32x32x16_bf16(pa2, (bf16x8){l2[0], l2[1], l2[2], l2[3], h2[0], h2[1], h2[2], h2[3]}, o[d0], 0, 0, 0);   \
        o[d0] = __builtin_amdgcn_mfma_f32_32x32x16_bf16(pa3, (bf16x8){l3[0], l3[1], l3[2], l3[3], h3[0], h3[1], h3[2], h3[3]}, o[d0], 0, 0, 0); } while (0)
    PV_D0(0); PV_D0(1); PV_D0(2); PV_D0(3);
#undef PV_D0
#undef TRRD
}

struct BlockRef { const u16* Q; const u16* K; const u16* V; const u16* G; unsigned char* Y; const unsigned long long* M; int P0; float nslope;
    int ja, jb;
    int role;
    float* slab; unsigned* flag; int nother; int dry; };
constexpr int SLAB_FLOATS = 8 * 64 * 64 + 8 * 128;
constexpr int FLAG_STRIDE = 64;
struct NextRef { const u16* Q; const u16* K; const u16* V; int P0; int ja; };
struct Seam { bf16x8 qr[8]; bf16x8 st_v0, st_v1, st_k0, st_k1; };
#define ROW(p, k0, rr) ((p) + (size_t)((k0) + (rr)) * PITCH + sc)
#define VMW() asm volatile("s_waitcnt vmcnt(0)" ::: "memory")
#define VMWN(n) asm volatile("s_waitcnt vmcnt(%0)" :: "i"(n) : "memory")
#define SLOAD_H(Kp, Vp, k0) do { S.st_v0 = load8(ROW(Vp, k0, sr)); S.st_v1 = load8(ROW(Vp, k0, 32 + sr));              \
                         S.st_k0 = load8(ROW(Kp, k0, sr)); S.st_k1 = load8(ROW(Kp, k0, 32 + sr)); } while (0)
#define SWRITE_HK(bf) do { *(bf16x8*)(K_lds + (bf) * SHM_K + kws) = S.st_k0; *(bf16x8*)(K_lds + (bf) * SHM_K + kws + 32 * 256) = S.st_k1; } while (0)
#define SWRITE_HV(bf) do { *(bf16x8*)(V_lds + (bf) * SHM_V + vst0) = S.st_v0; *(bf16x8*)(V_lds + (bf) * SHM_V + vst1) = S.st_v1; } while (0)
#define SWRITE_H(bf) do { SWRITE_HV(bf); SWRITE_HK(bf); } while (0)
template <int MODE>
__device__ __forceinline__ void attn_prime(const BlockRef& cur, char* lds, Seam& S, int wave_) {
    int tid_; asm volatile("v_mbcnt_lo_u32_b32 %0, -1, 0\n\tv_mbcnt_hi_u32_b32 %0, -1, %0\n\tv_lshl_add_u32 %0, %1, 6, %0" : "=&v"(tid_) : "s"(wave_)); const int tid = tid_, wid = __builtin_amdgcn_readfirstlane(tid >> 6), lane = tid & 63, r32 = lane & 31, hi = lane >> 5;
    const int sr = tid >> 4, sc = (tid & 15) * 8, kws = KSWZ(sr, sc * 2); char* K_lds = lds + 2 * SHM_V;
    const int kb0 = cur.ja * KVBLK;
#pragma unroll
    for (int d0 = 0; d0 < 8; ++d0) S.qr[d0] = load8(cur.Q + (size_t)(cur.P0 + wid * QBLK + r32) * PITCH + d0 * 16 + hi * 8);
    SLOAD_H(cur.K, cur.V, kb0); VMW(); SWRITE_HK(0);
    __syncthreads();
}
template <int MODE>
__device__ __forceinline__ void modify(f32x16& p0, f32x16& p1, int jt, int cw, int qpos, int hi, const float* bt, float nslope, u32x2 mw) {
    const int rel0 = qpos - jt * KVBLK - 4 * hi;
    if (MODE == 0) {
        if (jt <= cw - 3) { const float cb = bt[256];
#pragma unroll
            for (int r = 0; r < 16; ++r) { p0[r] += cb; p1[r] += cb; } }
        else {
#pragma unroll
            for (int r = 0; r < 16; ++r) { const int c = (r & 3) + 8 * (r >> 2);
                int i0 = rel0 - c, i1 = rel0 - c - 32;
                i0 = i0 < -128 ? -128 : (i0 > 128 ? 128 : i0); i1 = i1 < -128 ? -128 : (i1 > 128 ? 128 : i1);
                p0[r] += bt[i0 + 128]; p1[r] += bt[i1 + 128]; } }
    } else {
        const float NEG = -__builtin_inff();
        const float fq = (float)rel0;
        const unsigned w0 = mw.x >> (4 * hi), w1 = mw.y >> (4 * hi);
#pragma unroll
        for (int r = 0; r < 16; ++r) { const int c = (r & 3) + 8 * (r >> 2);
            const float t0 = fq - (float)c, t1 = fq - (float)(c + 32);
            float a0 = fmaf(fabsf(t0), nslope, p0[r]), a1 = fmaf(fabsf(t1), nslope, p1[r]);
            p0[r] = ((w0 >> c) & 1u) ? a0 : NEG; p1[r] = ((w1 >> c) & 1u) ? a1 : NEG; }
    }
}
template <int MODE>
__device__ __forceinline__ void attn_block(const BlockRef& cur, const NextRef& nxt, char* lds, Seam& S, int wave_) {
    int tid_; asm volatile("v_mbcnt_lo_u32_b32 %0, -1, 0\n\tv_mbcnt_hi_u32_b32 %0, -1, %0\n\tv_lshl_add_u32 %0, %1, 6, %0" : "=&v"(tid_) : "s"(wave_)); const int tid = tid_, wid = __builtin_amdgcn_readfirstlane(tid >> 6), lane = tid & 63, r32 = lane & 31, hi = lane >> 5;
    const int j_lo = cur.ja;
    const int NT = cur.jb - cur.ja;
    const int kbn = nxt.ja * KVBLK;
    const int cw = cur.P0 / KVBLK + (wid >> 1);
    const int qpos = cur.P0 + wid * QBLK + r32;
    char* V_lds = lds; char* K_lds = lds + 2 * SHM_V;
    float* ws = (float*)(lds + LDS_WS) + wid * 64; float* li_l = ws, * al_l = ws + 32;
    const float* bt = (const float*)(lds + LDS_BT);
    float m_reg = -1e30f, l_reg = 0; f32x16 o[4] = {};
    const int sr = tid >> 4, sc = (tid & 15) * 8, vst0 = v_st(sr, sc), vst1 = v_st(32 + sr, sc), kws = KSWZ(sr, sc * 2);
    const int vb0 = (int)(uintptr_t)V_lds + v_rd_base(lane);
    const u16* Kh = cur.K; const u16* Vh = cur.V;
    const unsigned long long* mrow = cur.M + qpos;
#define RESC(a) do { if (__any((a) < 1.f)) { if (hi == 0) al_l[r32] = (a); asm volatile("s_waitcnt lgkmcnt(0)" ::: "memory");              \
                     for (int d_ = 0; d_ < 4; ++d_) for (int r = 0; r < 16; ++r) o[d_][r] *= al_l[crow(r, hi)]; } } while (0)
#define KBASE(t) (((cur.dry & 1) ? 0 : (j_lo + (t))) * KVBLK)
#define ACT(t) (MODE == 0 ? ((j_lo + (t)) <= cw && (j_lo + (t)) >= cw - 8) : ((j_lo + (t)) <= cw))
#define MLOAD(t) ((MODE == 1 && ACT(t)) ? *(const u32x2*)(mrow + (size_t)((cur.dry & 2) ? 0 : (j_lo + (t))) * SEQ) : (u32x2){0u, 0u})
#define MODT(P0_, P1_, t, MW) do { if (ACT(t)) modify<MODE>(P0_, P1_, j_lo + (t), cw, qpos, hi, bt, cur.nslope, MW); } while (0)
#define SEAM_K0() do { VMWN(8); SWRITE_HK(0); SBAR(); } while (0)
    f32x16 pA0, pA1, pB0, pB1; float alA, alB; bf16x8 pa0, pa1, pa2, pa3; u32x2 mwA, mwB;
    SWRITE_HV(0); SBAR();
    mwA = MLOAD(0);
    if (NT > 1) { SLOAD_H(Kh, Vh, KBASE(1)); }
    SBAR(); qkt<0>(pA0, pA1, K_lds, r32, hi, S.qr, ACT(0));
    MODT(pA0, pA1, 0, mwA); partialSM(pA0, pA1, m_reg, alA);
    if (NT > 1) { VMW(); SWRITE_H(1); }
    __syncthreads();
#define HALF_STEP(PX0, PX1, alX, mwX, PY0, PY1, alY, t, KB, VB, SB) do {                                                      \
        SBAR(); mwX = MLOAD(t); qkt<KB>(PX0, PX1, K_lds, r32, hi, S.qr, ACT(t));                                             \
        finishSM(PY0, PY1, alY, l_reg, pa0, pa1, pa2, pa3); SBAR();                                                           \
        if ((t) + 1 < NT) { SLOAD_H(Kh, Vh, KBASE((t) + 1)); SBAR(); }                                                        \
        pv_tile<VB>(o, vb0, pa0, pa1, pa2, pa3, ACT((t) - 1)); MODT(PX0, PX1, (t), mwX); partialSM(PX0, PX1, m_reg, alX);    \
        __syncthreads();                                                                                                      \
        if ((t) + 1 < NT) { VMW(); SWRITE_H(SB); }                                                                            \
        RESC(alX); __syncthreads(); } while (0)
    for (int t = 1; t + 1 < NT; t += 2) {
        HALF_STEP(pB0, pB1, alB, mwB, pA0, pA1, alA, t, 1, 0, 0);
        HALF_STEP(pA0, pA1, alA, mwA, pB0, pB1, alB, t + 1, 0, 1, 1);
    }
    const bool even = (NT & 1) == 0;
    if (even) { SBAR(); mwB = MLOAD(NT - 1); qkt<1>(pB0, pB1, K_lds, r32, hi, S.qr, ACT(NT - 1)); SBAR(); }
    SLOAD_H(nxt.K, nxt.V, kbn); SBAR();
#pragma unroll
    for (int d0 = 0; d0 < 8; ++d0) S.qr[d0] = load8(nxt.Q + (size_t)(nxt.P0 + wid * QBLK + r32) * PITCH + d0 * 16 + hi * 8);
    SBAR();
    finishSM(pA0, pA1, alA, l_reg, pa0, pa1, pa2, pa3); SBAR();
    pv_tile<0>(o, vb0, pa0, pa1, pa2, pa3, ACT(even ? NT - 2 : NT - 1));
    if (even) { MODT(pB0, pB1, NT - 1, mwB); partialSM(pB0, pB1, m_reg, alB); __syncthreads(); RESC(alB);
        finishSM(pB0, pB1, alB, l_reg, pa0, pa1, pa2, pa3); SBAR(); pv_tile<1>(o, vb0, pa0, pa1, pa2, pa3, ACT(NT - 1)); }
    SBAR(); SEAM_K0();
    if (cur.dry) {
    } else if (cur.role == 1) {
        float* so = cur.slab + wid * 4096 + lane;
#pragma unroll
        for (int d0 = 0; d0 < 4; ++d0)
#pragma unroll
            for (int r = 0; r < 16; ++r) so[(d0 * 16 + r) * 64] = o[d0][r];
        float* sm = cur.slab + 8 * 4096 + wid * 128 + lane; sm[0] = m_reg; sm[64] = l_reg;
        asm volatile("s_waitcnt vmcnt(0)" ::: "memory");
        __syncthreads();
        if (tid == 0) { __builtin_amdgcn_fence(__ATOMIC_RELEASE, "agent"); asm volatile("s_waitcnt vmcnt(0)" ::: "memory");
                        __hip_atomic_store(cur.flag, 1u, __ATOMIC_RELAXED, __HIP_MEMORY_SCOPE_AGENT); }
    } else {
        if (cur.role == 2) {
            if (tid == 0) {
                for (int p = 0; p < cur.nother; ++p) { unsigned sp = 0u;
                    while (__hip_atomic_load(cur.flag + p * FLAG_STRIDE, __ATOMIC_RELAXED, __HIP_MEMORY_SCOPE_AGENT) == 0u) { __builtin_amdgcn_s_sleep(2); if (++sp > (1u << 22)) break; } }
                __builtin_amdgcn_fence(__ATOMIC_ACQUIRE, "agent"); asm volatile("s_waitcnt vmcnt(0)" ::: "memory");
            }
            __syncthreads();
            float* tab = (float*)(lds + LDS_MT) + wid * 96;
            const float* s0 = cur.slab; const float* s1 = cur.slab + SLAB_FLOATS; const bool two = cur.nother == 2;
            const float m0 = s0[8 * 4096 + wid * 128 + lane], l0 = s0[8 * 4096 + wid * 128 + 64 + lane];
            const float m1 = two ? s1[8 * 4096 + wid * 128 + lane] : -1e30f, l1 = two ? s1[8 * 4096 + wid * 128 + 64 + lane] : 0.f;
            const float mn = fmaxf(fmaxf(m_reg, m0), m1);
            const float fs = __builtin_amdgcn_exp2f(m_reg - mn), f0 = __builtin_amdgcn_exp2f(m0 - mn), f1 = __builtin_amdgcn_exp2f(m1 - mn);
            l_reg = l_reg * fs + l0 * f0 + l1 * f1;
            if (hi == 0) { tab[r32] = fs; tab[32 + r32] = f0; tab[64 + r32] = f1; }
            asm volatile("s_waitcnt lgkmcnt(0)" ::: "memory");
            const float* so0 = s0 + wid * 4096 + lane; const float* so1 = s1 + wid * 4096 + lane;
#pragma unroll
            for (int d0 = 0; d0 < 4; ++d0)
#pragma unroll
                for (int rb = 0; rb < 16; rb += 8) { float a0[8];
#pragma unroll
                    for (int r = 0; r < 8; ++r) a0[r] = so0[(d0 * 16 + rb + r) * 64];
#pragma unroll
                    for (int r = 0; r < 8; ++r) { const int rw = crow(rb + r, hi); o[d0][rb + r] = o[d0][rb + r] * tab[rw] + a0[r] * tab[32 + rw]; } __builtin_amdgcn_sched_barrier(0); }
            if (two) {
#pragma unroll
                for (int d0 = 0; d0 < 4; ++d0)
#pragma unroll
                    for (int rb = 0; rb < 16; rb += 8) { float a1[8];
#pragma unroll
                        for (int r = 0; r < 8; ++r) a1[r] = so1[(d0 * 16 + rb + r) * 64];
#pragma unroll
                        for (int r = 0; r < 8; ++r) { const int rw = crow(rb + r, hi); o[d0][rb + r] += a1[r] * tab[64 + rw]; } __builtin_amdgcn_sched_barrier(0); }
            }
        }
    {
        const size_t row0 = (size_t)(cur.P0 + wid * QBLK);
        const int erow = lane >> 3, ech = (lane & 7) * 8;
        if (hi == 0) li_l[r32] = l_reg; asm volatile("s_waitcnt lgkmcnt(0)" ::: "memory");
        float rli[16];
#pragma unroll
        for (int r = 0; r < 16; ++r) rli[r] = __builtin_amdgcn_rcpf(li_l[crow(r, hi)]);
        u16* stg = (u16*)(V_lds + wid * 4096);
#pragma unroll
        for (int half = 0; half < 2; ++half) {
            u32x4 gv[4];
#pragma unroll
            for (int i = 0; i < 4; ++i) gv[i] = *(const u32x4*)(cur.G + (row0 + i * 8 + erow) * PITCH + half * 64 + ech);
#pragma unroll
            for (int r = 0; r < 16; ++r) { const int orow = crow(r, hi);
#pragma unroll
                for (int dd = 0; dd < 2; ++dd) { const float v = o[2 * half + dd][r] * rli[r];
                    const float vn = __int_as_float(__builtin_amdgcn_mov_dpp(__float_as_int(v), 0xB1, 0xF, 0xF, true));
                    if ((r32 & 1) == 0) *(unsigned*)(stg + orow * 64 + dd * 32 + r32) = cvtpk(v, vn); } }
            asm volatile("s_waitcnt lgkmcnt(0)" ::: "memory");
#pragma unroll
            for (int it = 0; it < 4; ++it) { const int row = it * 8 + erow;
                const u32x4 ov = *(const u32x4*)(stg + row * 64 + ech); const u32x4 g4 = gv[it]; int y0 = 0, y1 = 0;
#pragma unroll
                for (int e = 0; e < 4; ++e) {
                    const float g0 = __uint_as_float(g4[e] << 16), g1 = __uint_as_float(g4[e] & 0xffff0000u);
                    const float s0 = g0 * __builtin_amdgcn_rcpf(1.f + __builtin_amdgcn_exp2f(-1.4426950408889634f * g0)) * Y8_SCALE;
                    const float s1 = g1 * __builtin_amdgcn_rcpf(1.f + __builtin_amdgcn_exp2f(-1.4426950408889634f * g1)) * Y8_SCALE;
                    const float a = __uint_as_float(ov[e] << 16) * s0, b = __uint_as_float(ov[e] & 0xffff0000u) * s1;
                    if (e == 0) y0 = __builtin_amdgcn_cvt_pk_fp8_f32(a, b, y0, false); else if (e == 1) y0 = __builtin_amdgcn_cvt_pk_fp8_f32(a, b, y0, true);
                    else if (e == 2) y1 = __builtin_amdgcn_cvt_pk_fp8_f32(a, b, y1, false); else y1 = __builtin_amdgcn_cvt_pk_fp8_f32(a, b, y1, true); }
                *(u32x2*)(cur.Y + (row0 + row) * YPITCH + half * 64 + ech) = (u32x2){(unsigned)y0, (unsigned)y1}; }
            asm volatile("s_waitcnt lgkmcnt(0)" ::: "memory");
        }
    }
    }
    __syncthreads();
#undef RESC
#undef KBASE
#undef ACT
#undef MLOAD
#undef MODT
#undef SEAM_K0
#undef HALF_STEP
}
#undef ROW
#undef VMW
#undef VMWN
#undef SLOAD_H
#undef SWRITE_HK
#undef SWRITE_HV
#undef SWRITE_H
#undef SBAR
#undef KSWZ
}
#ifndef REP_PHASE
#define REP_PHASE -1
#endif
namespace idx {
typedef unsigned short u16;
typedef short bf16x8 __attribute__((ext_vector_type(8)));
typedef float f32x16 __attribute__((ext_vector_type(16)));
typedef float f32x4 __attribute__((ext_vector_type(4)));
typedef unsigned u32x4 __attribute__((ext_vector_type(4)));
#define IDX_LAS __attribute__((address_space(3)))
constexpr int SEQ = 4096, PITCH = 1024, TOPK = 256;
constexpr int HW_WORDS = 16 * 260;
constexpr int LDS_S = 0, LDS_BYTES = 8 * HW_WORDS * 4;
constexpr float IDX_SCALE = 0.03125f;
__device__ __forceinline__ float bf2f(unsigned h) { return __uint_as_float(h << 16); }

__device__ __forceinline__ void unit(IDX_LAS unsigned char* lds, const u16* QI, const u16* KW, unsigned long long* Mb, int b, int t0, int wave_) {
    int tid_; asm volatile("v_mbcnt_lo_u32_b32 %0, -1, 0\n\tv_mbcnt_hi_u32_b32 %0, -1, %0\n\tv_lshl_add_u32 %0, %1, 6, %0" : "=&v"(tid_) : "s"(wave_)); const int tid = tid_, wid = __builtin_amdgcn_readfirstlane(tid >> 6), lane = tid & 63, c32 = lane & 31, hi = lane >> 5;
    const int c = t0 >> 6, N = 64 * (c + 1), nt32 = N >> 5, nt = c + 1;
    const size_t rb = (size_t)b * SEQ;
    IDX_LAS float* S = (IDX_LAS float*)(lds + LDS_S);
    bf16x8 af[4][4]; float wv[4][16];
#pragma unroll
    for (int j = 0; j < 4; ++j) {
        const int query = 2 * j + ((c32 >> 2) & 1), head = (c32 & 3) + 4 * (c32 >> 3);
        const u16* qp = QI + (rb + t0 + query) * PITCH + head * 64 + hi * 8;
#pragma unroll
        for (int ks = 0; ks < 4; ++ks) af[j][ks] = *(const bf16x8*)(qp + ks * 16);
        const u16* wp = KW + (rb + t0 + 2 * j + hi) * PITCH + 64;
        const u32x4 w0 = *(const u32x4*)wp, w1 = *(const u32x4*)(wp + 8);
#pragma unroll
        for (int e = 0; e < 4; ++e) { wv[j][2 * e] = bf2f(w0[e] & 0xffffu) * IDX_SCALE; wv[j][2 * e + 1] = __uint_as_float(w0[e] & 0xffff0000u) * IDX_SCALE;
                                      wv[j][8 + 2 * e] = bf2f(w1[e] & 0xffffu) * IDX_SCALE; wv[j][8 + 2 * e + 1] = __uint_as_float(w1[e] & 0xffff0000u) * IDX_SCALE; }
    }
    const u16* kbase = KW + (rb + c32) * PITCH + hi * 8;
    bf16x8 bn[4];
    if (wid < nt32) {
#pragma unroll
        for (int ks = 0; ks < 4; ++ks) bn[ks] = *(const bf16x8*)(kbase + (size_t)(wid * 32) * PITCH + ks * 16);
    }
    for (int kt = wid; kt < nt32; kt += 8) {
        bf16x8 bc[4];
#pragma unroll
        for (int ks = 0; ks < 4; ++ks) bc[ks] = bn[ks];
        if (kt + 8 < nt32) {
#pragma unroll
            for (int ks = 0; ks < 4; ++ks) bn[ks] = *(const bf16x8*)(kbase + (size_t)((kt + 8) * 32) * PITCH + ks * 16);
        }
#pragma unroll
        for (int j = 0; j < 4; ++j) {
            f32x16 acc = {};
#pragma unroll
            for (int ks = 0; ks < 4; ++ks) acc = __builtin_amdgcn_mfma_f32_32x32x16_bf16(af[j][ks], bc[ks], acc, 0, 0, 0);
            float s = 0.f;
#pragma unroll
            for (int r = 0; r < 16; ++r) s = fmaf(wv[j][r], fmaxf(acc[r], 0.f), s);
            S[(2 * j + hi) * SEQ + kt * 32 + c32] = s;
        }
    }
    __syncthreads();
    {
        const IDX_LAS float* row = S + wid * SEQ;
        unsigned key[64];
#pragma unroll
        for (int g = 0; g < 8; ++g) {
            if (g * 8 < nt) {
#pragma unroll
                for (int e = 0; e < 8; ++e) { const int i = g * 8 + e; const unsigned u = __float_as_uint(row[i * 64 + lane]);
                    const unsigned k = u ^ ((unsigned)((int)u >> 31) | 0x80000000u); key[i] = (i < nt) ? k : 0u; }
            } else {
#pragma unroll
                for (int e = 0; e < 8; ++e) key[g * 8 + e] = 0u;
            }
        }
        __syncthreads();
        IDX_LAS unsigned* hw = (IDX_LAS unsigned*)lds + wid * HW_WORDS;
        const unsigned dummy = 4096u + (unsigned)lane;
        const unsigned rot = (unsigned)lane * 4u;
#define IDX_CLEAR() do { _Pragma("unroll") for (int j = 0; j < 16; ++j) *(IDX_LAS u32x4*)(hw + j * 256 + lane * 4) = (u32x4){0u, 0u, 0u, 0u}; hw[4096 + lane] = 0u; } while (0)
#define IDX_SCAN(BIN, ABOVE, CNT) do { \
            asm volatile("s_waitcnt lgkmcnt(0)" ::: "memory"); \
            unsigned tot_ = 0u; \
            _Pragma("unroll") for (int j = 0; j < 16; ++j) { const u32x4 v_ = *(IDX_LAS u32x4*)(hw + lane * 64 + ((rot + 4u * j) & 63u)); tot_ += (v_[0] + v_[1]) + (v_[2] + v_[3]); } \
            unsigned v1_ = tot_; \
            _Pragma("unroll") for (int o = 1; o < 64; o <<= 1) { const unsigned t_ = __shfl_down(v1_, o); if (lane + o < 64) v1_ += t_; } \
            const unsigned ab1_ = v1_ - tot_; \
            const unsigned long long f1_ = __ballot(ab1_ < (unsigned)kk && (unsigned)kk <= ab1_ + tot_); \
            const int L_ = (int)__builtin_ctzll(f1_); \
            const unsigned aL_ = (unsigned)__shfl((int)ab1_, L_); \
            const unsigned c_ = hw[L_ * 64 + lane]; \
            unsigned v2_ = c_; \
            _Pragma("unroll") for (int o = 1; o < 64; o <<= 1) { const unsigned t_ = __shfl_down(v2_, o); if (lane + o < 64) v2_ += t_; } \
            const unsigned ab2_ = v2_ - c_ + aL_; \
            const unsigned long long f2_ = __ballot(ab2_ < (unsigned)kk && (unsigned)kk <= ab2_ + c_); \
            const int l2_ = (int)__builtin_ctzll(f2_); \
            BIN = (unsigned)(L_ * 64 + l2_); ABOVE = (unsigned)__shfl((int)ab2_, l2_); CNT = (unsigned)__shfl((int)c_, l2_); } while (0)
        int kk = TOPK; unsigned lo, bin, above, ties;
        IDX_CLEAR();
#pragma unroll
        for (int g = 0; g < 8; ++g) if (g * 8 < nt) {
#pragma unroll
            for (int e = 0; e < 8; ++e) __hip_atomic_fetch_add(hw + (key[g * 8 + e] >> 20), 1u, __ATOMIC_RELAXED, __HIP_MEMORY_SCOPE_WORKGROUP);
        }
        IDX_SCAN(bin, above, ties); lo = bin << 20; kk -= (int)above;
        if (ties != (unsigned)kk) {
            IDX_CLEAR();
#pragma unroll
            for (int g = 0; g < 8; ++g) if (g * 8 < nt) {
#pragma unroll
                for (int e = 0; e < 8; ++e) { unsigned t = (key[g * 8 + e] - lo) >> 8; t = t < dummy ? t : dummy;
                    __hip_atomic_fetch_add(hw + t, 1u, __ATOMIC_RELAXED, __HIP_MEMORY_SCOPE_WORKGROUP); }
            }
            IDX_SCAN(bin, above, ties); lo += bin << 8; kk -= (int)above;
            if (ties != (unsigned)kk) {
                IDX_CLEAR();
#pragma unroll
                for (int g = 0; g < 8; ++g) if (g * 8 < nt) {
#pragma unroll
                    for (int e = 0; e < 8; ++e) { unsigned t = key[g * 8 + e] - lo; t = t < 256u ? t : dummy;
                        __hip_atomic_fetch_add(hw + t, 1u, __ATOMIC_RELAXED, __HIP_MEMORY_SCOPE_WORKGROUP); }
                }
                IDX_SCAN(bin, above, ties); lo += bin; kk -= (int)above;
            }
        }
#undef IDX_CLEAR
#undef IDX_SCAN
        const unsigned thr = lo; const unsigned need = (unsigned)kk;
        const int ntw = 4 * (c >> 2) + 4;
        unsigned mlo = 0u, mhi = 0u;
        if (ties == need) {
#pragma unroll
            for (int g = 0; g < 8; ++g) if (g * 8 < nt) {
#pragma unroll
                for (int e = 0; e < 8; ++e) { const int i = g * 8 + e; const unsigned long long bal = __ballot(key[i] >= thr && i < nt);
                    if (lane == i) { mlo = (unsigned)bal; mhi = (unsigned)(bal >> 32); } }
            }
        } else {
            unsigned running = 0u;
#pragma unroll
            for (int i = 0; i < 64; ++i) {
                if (i < nt) { const bool eq = key[i] == thr; const unsigned long long eb = __ballot(eq);
                    const unsigned rank = running + __builtin_amdgcn_mbcnt_hi((unsigned)(eb >> 32), __builtin_amdgcn_mbcnt_lo((unsigned)eb, 0u));
                    const bool sel = (key[i] > thr) || (eq && rank < need);
                    const unsigned long long bal = __ballot(sel);
                    if (lane == i) { mlo = (unsigned)bal; mhi = (unsigned)(bal >> 32); }
                    running += (unsigned)__popcll(eb); }
            }
        }
        if (lane < ntw) Mb[(size_t)lane * SEQ + t0 + wid] = ((unsigned long long)mhi << 32) | mlo;
    }
    __syncthreads();
}
}
#define GAS __attribute__((address_space(1)))
#define LAS __attribute__((address_space(3)))
typedef unsigned short bf16;
typedef unsigned v4u __attribute__((ext_vector_type(4)));
typedef float f32x4 __attribute__((ext_vector_type(4)));
typedef short bf16x8 __attribute__((ext_vector_type(8)));
typedef GAS unsigned gu32;
typedef GAS unsigned long long gu64;
#define RLX_AGENT __ATOMIC_RELAXED, __HIP_MEMORY_SCOPE_AGENT
#define LDS_WAIT() asm volatile("s_waitcnt lgkmcnt(0)" ::: "memory")
#define VM_WAIT() asm volatile("s_waitcnt vmcnt(0)" ::: "memory")
__device__ __forceinline__ unsigned long long rt() { return __builtin_amdgcn_s_memrealtime(); }
__device__ __forceinline__ unsigned f2bf(float f) { unsigned u = __builtin_bit_cast(unsigned, f); return (u + 0x7fffu + ((u >> 16) & 1u)) >> 16; }
__device__ __forceinline__ unsigned pk2(float lo, float hi) { return f2bf(lo) | (f2bf(hi) << 16); }

#define XB_TMO      128
#define XB_XCNT(j)  (256  + 64 * (j))
#define XB_XSUB(j)  (1280 + 64 * (j))
#define XB_XGEN(j)  (2304 + 64 * (j))
#define XB_TOP      3328
#define XB_TOPGEN   3392
#define XCD_BAR_WORDS 3456
#define XB_SPIN_CAP (1u << 18)

__device__ __forceinline__ unsigned xb_ld(unsigned* p)              { return __hip_atomic_load(p, __ATOMIC_RELAXED, __HIP_MEMORY_SCOPE_AGENT); }
__device__ __forceinline__ unsigned xb_add(unsigned* p, unsigned v) { return __hip_atomic_fetch_add(p, v, __ATOMIC_RELAXED, __HIP_MEMORY_SCOPE_AGENT); }
__device__ __forceinline__ unsigned xb_xcc_id() { return (unsigned)__builtin_amdgcn_s_getreg((3 << 11) | 20) & 0xFu; }
#define XB_SPIN(cond, bar) do { unsigned _sp = 0; while (cond) { __builtin_amdgcn_s_sleep(1); \
    if ((++_sp & 255u) == 0u) { if (xb_ld(&(bar)[XB_TMO])) break; if (_sp > XB_SPIN_CAP) { atomicAdd(&(bar)[XB_TMO], 1u); break; } } } } while (0)

struct XcdBarrier {
    unsigned* bar; unsigned x;
    volatile LAS unsigned* st;
};

__device__ __forceinline__ XcdBarrier xcd_barrier_post(unsigned* bar, volatile LAS unsigned* st) {
    XcdBarrier b; b.bar = bar; b.x = xb_xcc_id(); b.st = st;
    if (threadIdx.x == 0) (void)xb_add(&bar[XB_XCNT(b.x)], 1u);
    return b;
}
__device__ __forceinline__ void xcd_barrier_complete(unsigned* bar, unsigned x, unsigned& nloc, unsigned& nx) {
    const unsigned G = gridDim.x * gridDim.y * gridDim.z;
    unsigned sum, cnt, mine, sp = 0u;
    for (;;) {
        sum = 0u; cnt = 0u; mine = 0u;
#pragma unroll
        for (unsigned j = 0; j < 16; ++j) { const unsigned c = xb_ld(&bar[XB_XCNT(j)]); sum += c; cnt += (c > 0u) ? 1u : 0u; mine = (j == x) ? c : mine; }
        if (sum == G) break;
        __builtin_amdgcn_s_sleep(1);
        if ((++sp & 255u) == 0u) { if (xb_ld(&bar[XB_TMO])) break; if (sp > XB_SPIN_CAP) { atomicAdd(&bar[XB_TMO], 1u); break; } }
    }
    nloc = mine > 0u ? mine : 1u; nx = cnt > 0u ? cnt : 1u;
}

__device__ __forceinline__ void xcd_barrier(const XcdBarrier& b) {
    asm volatile("s_waitcnt vmcnt(0)" ::: "memory");
    __syncthreads();
    if (threadIdx.x == 0) {
        unsigned* bar = b.bar;
        __builtin_amdgcn_s_waitcnt(0);
        unsigned nloc = b.st[0], nx = b.st[1];
        if (nloc == 0u) { xcd_barrier_complete(bar, b.x, nloc, nx); b.st[0] = nloc; b.st[1] = nx; }
        const unsigned old = xb_add(&bar[XB_XSUB(b.x)], 1u);
        const unsigned gen = old / nloc;
        if (old + 1u == (gen + 1u) * nloc) {
            __builtin_amdgcn_fence(__ATOMIC_RELEASE, "agent");
            asm volatile("s_waitcnt vmcnt(0)" ::: "memory");
            const unsigned og = xb_add(&bar[XB_TOP], 1u);
            const unsigned tg = og / nx;
            if (og + 1u == (tg + 1u) * nx) xb_add(&bar[XB_TOPGEN], 1u);
            else XB_SPIN(xb_ld(&bar[XB_TOPGEN]) == tg, bar);
            __builtin_amdgcn_fence(__ATOMIC_ACQUIRE, "agent");
            xb_add(&bar[XB_XGEN(b.x)], 1u);
            asm volatile("s_waitcnt vmcnt(0)" ::: "memory");
        } else {
            XB_SPIN(xb_ld(&bar[XB_XGEN(b.x)]) == gen, bar);
            __builtin_amdgcn_fence(__ATOMIC_ACQUIRE, "agent");
            asm volatile("s_waitcnt vmcnt(0)" ::: "memory");
        }
    }
    __syncthreads();
}

constexpr int NWAVES = 8;
constexpr int BATCH = 2, T = 4096, DM = 2048, M = BATCH * T;
constexpr int D_IN = 9296, N8 = 8192, NB = D_IN - N8, NB_PAD = 1280;
constexpr float W8_SCALE = 64.f;
constexpr int NTENS = 10, TP = 1024;
constexpr float EPS = 1e-6f;
constexpr float LOG2E = 1.4426950408889634f;
constexpr float C2 = 0.08838834764831845f * 1.4426950408889634f;
constexpr int MAX_REL = 128, NREL = 2 * MAX_REL + 1;

constexpr size_t MiB = 1u << 20;
constexpr size_t WS_CTL = 0, CTL_ZERO_BYTES = 1 * MiB;
constexpr size_t WS_W8 = 1 * MiB;
constexpr size_t WS_WB = 17 * MiB;
constexpr size_t WS_XN8 = 22 * MiB;
constexpr size_t WS_WOUT = 38 * MiB;
constexpr size_t WS_XN = 46 * MiB;
constexpr size_t WS_PROJ = 78 * MiB;
constexpr size_t WS_MASK = 238 * MiB;
constexpr size_t WS_PART = 242 * MiB;
constexpr size_t WS_END = 243 * MiB;
constexpr int CW_BAR = 4096;
constexpr int CW_FLAG = 16384;
constexpr size_t WS_SLAB = WS_W8;
static_assert(256 * (size_t)att::SLAB_FLOATS * 4 <= 37 * MiB && (CW_FLAG + 256 * 64) * 4 <= (int)CTL_ZERO_BYTES, "slabs / flags");

constexpr int RING_OFF = 0, RING_BYTES = 139264;
constexpr int LDSCTL_OFF = RING_BYTES, MISC_OFF = LDSCTL_OFF + 320;
constexpr int LDS_BYTES = 147456;
static_assert(MISC_OFF + 128 <= LDS_BYTES && idx::LDS_BYTES <= RING_BYTES && att::LDS_BYTES <= RING_BYTES && pg8::STAGE_BYTES <= RING_BYTES, "LDS map");

__device__ __forceinline__ int lane_id_asm() { int l; asm volatile("v_mbcnt_lo_u32_b32 %0, -1, 0\n\tv_mbcnt_hi_u32_b32 %0, -1, %0" : "=&v"(l)); return l; }
struct Frame {
    LAS unsigned char* lds;
    volatile LAS unsigned* MISC;
    gu32* ctl;
    int tid, lane, wave;
    int vcu, G;
};

__device__ __forceinline__ float wave_sum(float v) {
#pragma unroll
    for (int o = 1; o < 64; o <<= 1) v += __shfl_xor(v, o);
    return v;
}
template <bool FP8OUT>
__device__ __forceinline__ void p0_transpose_item(const float* W, int K, int ldw, int n_base, int n_lim, int NP, void* WTv, float scale, LAS float* scr, int item, int lane) {
    const int nblk = NP / 32, kb = item / nblk, nb = item % nblk, k0 = 64 * kb, n0 = 32 * nb;
    const bool inb = (n_base + n0 + (lane & 31)) < n_lim;
#pragma unroll 8
    for (int i = 0; i < 32; ++i) { const int kk = 2 * i + (lane >> 5); scr[kk * 33 + (lane & 31)] = inb ? W[(size_t)(k0 + kk) * ldw + n_base + n0 + (lane & 31)] * scale : 0.f; }
    LDS_WAIT(); asm volatile("" ::: "memory");
    const int c = lane & 7;
#pragma unroll
    for (int j = 0; j < 4; ++j) { const int n = (lane >> 3) + 8 * j; const LAS float* s = scr + (8 * c) * 33 + n;
        if constexpr (FP8OUT) {
            int lo = __builtin_amdgcn_cvt_pk_fp8_f32(s[0 * 33], s[1 * 33], 0, false); lo = __builtin_amdgcn_cvt_pk_fp8_f32(s[2 * 33], s[3 * 33], lo, true);
            int hi = __builtin_amdgcn_cvt_pk_fp8_f32(s[4 * 33], s[5 * 33], 0, false); hi = __builtin_amdgcn_cvt_pk_fp8_f32(s[6 * 33], s[7 * 33], hi, true);
            *(GAS unsigned long long*)((unsigned char*)WTv + (size_t)(n0 + n) * K + k0 + 8 * c) = ((unsigned long long)(unsigned)hi << 32) | (unsigned)lo;
        } else {
            v4u o; o.x = pk2(s[0 * 33], s[1 * 33]); o.y = pk2(s[2 * 33], s[3 * 33]); o.z = pk2(s[4 * 33], s[5 * 33]); o.w = pk2(s[6 * 33], s[7 * 33]);
            *(GAS v4u*)((bf16*)WTv + (size_t)(n0 + n) * K + k0 + 8 * c) = o; } }
    LDS_WAIT(); asm volatile("" ::: "memory");
}
__device__ __forceinline__ void rms_row_to_bf16(int lane, const float* xrow, const float* gain, bf16* orow, unsigned char* orow8) {
    const GAS f32x4* xr = (const GAS f32x4*)xrow + lane; const GAS f32x4* gr = (const GAS f32x4*)gain + lane;
    f32x4 v[8]; float s = 0.f;
#pragma unroll
    for (int j = 0; j < 8; ++j) { v[j] = xr[64 * j]; s += (v[j].x * v[j].x + v[j].y * v[j].y) + (v[j].z * v[j].z + v[j].w * v[j].w); }
    const float rstd = 1.f / sqrtf(wave_sum(s) * (1.f / DM) + EPS);
    GAS unsigned long long* o8 = (GAS unsigned long long*)orow + lane; GAS unsigned* o4 = (GAS unsigned*)orow8 + lane;
#pragma unroll
    for (int j = 0; j < 8; ++j) { const f32x4 g = gr[64 * j]; const float a = v[j].x * rstd * g.x, b = v[j].y * rstd * g.y, c = v[j].z * rstd * g.z, d = v[j].w * rstd * g.w;
        o8[64 * j] = (unsigned long long)pk2(a, b) | ((unsigned long long)pk2(c, d) << 32);
        int q = __builtin_amdgcn_cvt_pk_fp8_f32(a, b, 0, false); q = __builtin_amdgcn_cvt_pk_fp8_f32(c, d, q, true); o4[64 * j] = (unsigned)q; }
}


#ifdef DBG_CHECK
__device__ __forceinline__ float dbg_row(int mode, int lane, const bf16* Q, const bf16* K, const bf16* V, const bf16* G, const bf16* Yrow, const unsigned long long* Mb,
                                         const float* rel_bias_h, float nslope, int t) {
    const unsigned qw = *(const unsigned*)(Q + (size_t)t * 1024 + 2 * lane);
    const float q0 = __uint_as_float(qw << 16), q1 = __uint_as_float(qw & 0xffff0000u);
    const int c = t >> 6; const int s_lo = (mode == 0) ? ((c - 8) > 0 ? (c - 8) * 64 : 0) : 0, s_hi = (c + 1) * 64;
    float m = -1e30f, l = 0.f, o0 = 0.f, o1 = 0.f;
    for (int s = s_lo; s < s_hi; ++s) {
        if (mode == 1) { const unsigned long long w = Mb[(size_t)(s >> 6) * T + t]; if (!((w >> (s & 63)) & 1ull)) continue; }
        const unsigned kw = *(const unsigned*)(K + (size_t)s * 1024 + 2 * lane);
        float part = q0 * __uint_as_float(kw << 16) + q1 * __uint_as_float(kw & 0xffff0000u);
        float sc = wave_sum(part);
        if (mode == 0) { int r = t - s; r = r < -128 ? -128 : (r > 128 ? 128 : r); sc += rel_bias_h[r + 128] * LOG2E; }
        else { int d = t - s; d = d < 0 ? -d : d; sc += nslope * (float)d; }
        const float mn = fmaxf(m, sc), a = __builtin_amdgcn_exp2f(m - mn), p = __builtin_amdgcn_exp2f(sc - mn);
        const unsigned vw = *(const unsigned*)(V + (size_t)s * 1024 + 2 * lane);
        l = l * a + p; o0 = o0 * a + p * __uint_as_float(vw << 16); o1 = o1 * a + p * __uint_as_float(vw & 0xffff0000u); m = mn;
    }
    const unsigned gw = *(const unsigned*)(G + (size_t)t * 1024 + 2 * lane);
    const float g0 = __uint_as_float(gw << 16), g1 = __uint_as_float(gw & 0xffff0000u);
    const float y0 = o0 / l * (g0 / (1.f + expf(-g0))), y1 = o1 / l * (g1 / (1.f + expf(-g1)));
    const unsigned yw = *(const unsigned*)(Yrow + 2 * lane);
    float d = fmaxf(fabsf(y0 - __uint_as_float(yw << 16)), fabsf(y1 - __uint_as_float(yw & 0xffff0000u)));
#pragma unroll
    for (int o = 1; o < 64; o <<= 1) d = fmaxf(d, __shfl_xor(d, o));
    return d;
}
#endif

#ifndef REP_PHASE
#define REP_PHASE -1
#endif
#ifndef DRY_MODE
#define DRY_MODE 0
#endif
struct Args { const float* x; const float* norm_gain; const float* w_in; const float* rel_bias; const float* w_out; const float* final_gain; float* out; unsigned char* ws; };
__global__ void __launch_bounds__(NWAVES * 64, 2) skel_fwd(Args args) {
    extern __shared__ __attribute__((aligned(16))) unsigned char lds[];
    Frame F;
    F.lds = (LAS unsigned char*)lds;
    F.MISC = (volatile LAS unsigned*)(F.lds + MISC_OFF);
    F.wave = __builtin_amdgcn_readfirstlane((int)threadIdx.x >> 6); F.lane = lane_id_asm(); F.tid = F.wave * 64 + F.lane;
    F.G = gridDim.x; { const int bx = blockIdx.x; F.vcu = (F.G % 8 == 0) ? (bx % 8) * (F.G / 8) + bx / 8 : bx; }
    unsigned char* ws = args.ws;
    F.ctl = (gu32*)(ws + WS_CTL);
    unsigned char* W8 = ws + WS_W8; bf16* WB = (bf16*)(ws + WS_WB); unsigned char* XN8 = ws + WS_XN8; unsigned char* Wout8 = ws + WS_WOUT; bf16* XN = (bf16*)(ws + WS_XN); unsigned char* Y = (unsigned char*)XN;
    bf16* PROJ = (bf16*)(ws + WS_PROJ); unsigned long long* MASK = (unsigned long long*)(ws + WS_MASK); float* PART = (float*)(ws + WS_PART);
    for (int u = F.tid; u < (LDS_BYTES - LDSCTL_OFF) / 4; u += NWAVES * 64) ((LAS unsigned*)(F.lds + LDSCTL_OFF))[u] = 0u;
    __syncthreads();
    XcdBarrier bar = xcd_barrier_post((unsigned*)(F.ctl + CW_BAR), F.MISC + 8);
    const int gw = F.vcu * NWAVES + F.wave, NGW = F.G * NWAVES;
#ifdef DBG_TS
    unsigned long long ts_[8]; int nts_ = 0;
#define STAMP() do { ts_[nts_++] = rt(); } while (0)
#else
#define STAMP() do {} while (0)
#endif
    STAMP();

    for (int rep_ = 0; rep_ < (REP_PHASE == 0 ? 2 : 1); ++rep_) {
    {
        LAS float* scr = (LAS float*)(F.lds + RING_OFF + F.wave * 16384);
        constexpr int I_8 = (DM / 64) * (N8 / 32), I_B = (DM / 64) * (NB_PAD / 32), I_OUT = (DM / 64) * (DM / 32);
        for (int it = gw; it < I_8 + I_B + I_OUT; it += NGW) {
            if (it < I_8) p0_transpose_item<true>(args.w_in, DM, D_IN, 0, N8, N8, W8, W8_SCALE, scr, it, F.lane);
            else if (it < I_8 + I_B) p0_transpose_item<false>(args.w_in, DM, D_IN, N8, D_IN, NB_PAD, WB, 1.f, scr, it - I_8, F.lane);
            else p0_transpose_item<true>(args.w_out, DM, DM, 0, DM, DM, Wout8, W8_SCALE, scr, it - I_8 - I_B, F.lane);
        }
        for (int m = gw; m < M; m += NGW) rms_row_to_bf16(F.lane, args.x + (size_t)m * DM, args.norm_gain, XN + (size_t)m * DM, XN8 + (size_t)m * DM);
        for (int e = blockIdx.x * (NWAVES * 64) + F.tid; e < BATCH * 4 * 256; e += F.G * NWAVES * 64) {
            const int b = e / 1024, jt = (e >> 8) & 3, t = e & 255;
            MASK[((size_t)b * 64 + jt) * T + t] = (jt <= (t >> 6)) ? ~0ull : 0ull;
        }
    }
    xcd_barrier(bar); STAMP();
    }

    for (int rep_ = 0; rep_ < (REP_PHASE == 1 ? 2 : 1); ++rep_) {
    {
        {
            pg8::Gemm g{XN, WB, M, NB_PAD, DM}; pg8::StaticOrder S; S.init(M, NB_PAD, F.G, (int)blockIdx.x);
            pg8::EpiSplit E{PROJ, TP, TP, (size_t)M * TP, C2, 1.f, N8};
            pg8::gemm_phase<pg8::EpiSplit, pg8::StaticOrder, true, true, false>(F.lds + RING_OFF, g, S, E, F.wave);
        }
        {
            pg8::Gemm g{(const pg8::bf16_t*)XN8, (const pg8::bf16_t*)W8, M, N8, DM / 2}; pg8::StaticOrder S; S.init(M, N8, F.G, (int)blockIdx.x);
            pg8::EpiSplit E{PROJ, TP, TP, (size_t)M * TP, C2, 1.f / W8_SCALE, 0};
            pg8::gemm_phase<pg8::EpiSplit, pg8::StaticOrder, true, true, true>(F.lds + RING_OFF, g, S, E, F.wave);
        }
    }
    xcd_barrier(bar); STAMP();
    }

    for (int rep_ = 0; rep_ < (REP_PHASE == 2 ? 2 : 1); ++rep_) {
    {
        const size_t TS = (size_t)M * TP;
        for (int ra_ = 0; ra_ < (REP_PHASE == 20 ? 2 : 1); ++ra_)
        for (int a = F.vcu; a < 256; a += F.G) {
            const int bh = a >> 4, qb = a & 15, b = bh >> 3, h = bh & 7;
            float* bt = (float*)((char*)lds + RING_OFF + att::LDS_BT);
            for (int i = F.tid; i < NREL; i += NWAVES * 64) bt[i] = args.rel_bias[h * NREL + i] * LOG2E;
            const size_t ro = (size_t)b * T * TP + (size_t)h * 128;
            att::BlockRef cur{PROJ + 0 * TS + ro, PROJ + 1 * TS + ro, PROJ + 2 * TS + ro, PROJ + 3 * TS + ro, Y + (size_t)b * T * DM + h * 128, nullptr, qb * 256, 0.f,
                              (4 * qb - 8) > 0 ? (4 * qb - 8) : 0, 4 * qb + 4, 0, nullptr, nullptr, 0, 0};
            att::Seam S;
            att::NextRef nx{cur.Q, cur.K, cur.V, cur.P0, cur.ja};
            att::attn_prime<0>(cur, (char*)lds + RING_OFF, S, F.wave);
            att::attn_block<0>(cur, nx, (char*)lds + RING_OFF, S, F.wave);
        }
        __syncthreads();
        for (int ri_ = 0; ri_ < (REP_PHASE == 21 ? 2 : 1); ++ri_)
        for (int cu = (int)blockIdx.x; cu < 256; cu += F.G)
            for (int rnd = 0; rnd < 4; ++rnd) {
                const int u = (rnd & 1) ? (rnd * 256 + 255 - cu) : (rnd * 256 + cu);
                if (u >= 960) continue;
                const int c = 63 - (u >> 4), b = (u >> 3) & 1, t0 = c * 64 + (u & 7) * 8;
                idx::unit(F.lds + RING_OFF, PROJ + 8 * TS, PROJ + 9 * TS, MASK + (size_t)b * 64 * T, b, t0, F.wave);
            }
    }
    xcd_barrier(bar); STAMP();
    }

    for (int rep_ = 0; rep_ < (REP_PHASE == 3 ? 2 : 1); ++rep_) {
    {
        const size_t TS = (size_t)M * TP;
        for (int a = F.vcu; a < 256; a += F.G) {
            const int bh = a >> 4, k = a & 15, b = bh >> 3, h = bh & 7, lo = 34 * k, hi = lo + 34;
            const size_t ro = (size_t)b * T * TP + (size_t)h * 128;
            const float slope = __builtin_amdgcn_exp2f(-(float)(h + 1));
            float* slabs = (float*)(ws + WS_SLAB); unsigned* flags = (unsigned*)(F.ctl + CW_FLAG);
#define PIECE_OF(qb_) ({ const int Ls_ = 544 - 2 * ((qb_) + 1) * ((qb_) + 2), Le_ = Ls_ + 4 * ((qb_) + 1); const int a_ = lo > Ls_ ? lo : Ls_, e_ = hi < Le_ ? hi : Le_; (a_ >= e_) ? -1 : ((a_ - Ls_) | ((e_ - Ls_) << 8)); })
#define MAKE_REF(R, qb_) do { const int pc_ = PIECE_OF(qb_); const int ta_ = pc_ & 255, tb_ = pc_ >> 8, nt_ = 4 * ((qb_) + 1); \
                R.Q = PROJ + 4 * TS + ro; R.K = PROJ + 5 * TS + ro; R.V = PROJ + 6 * TS + ro; R.G = PROJ + 7 * TS + ro; R.Y = Y + (size_t)b * T * DM + 1024 + h * 128; R.M = MASK + (size_t)b * 64 * T; \
                R.P0 = (qb_) * 256; R.nslope = -slope * LOG2E; R.ja = ta_; R.jb = tb_; R.role = (ta_ == 0 && tb_ == nt_) ? 0 : (ta_ == 0 ? 2 : 1); \
                R.slab = slabs + (size_t)(R.role == 2 ? a + 1 : a) * att::SLAB_FLOATS; R.flag = flags + (R.role == 2 ? a + 1 : a) * att::FLAG_STRIDE; R.nother = (nt_ - tb_) > 34 ? 2 : 1; R.dry = (rep_ == 1) ? DRY_MODE : 0; } while (0)
            int qb = 15; while (PIECE_OF(qb) < 0) --qb;
            att::BlockRef cur; MAKE_REF(cur, qb);
            att::Seam S;
            att::attn_prime<1>(cur, (char*)lds + RING_OFF, S, F.wave);
            for (;;) {
                const int qn = qb - 1; const int pn = (qn >= 0) ? PIECE_OF(qn >= 0 ? qn : 0) : -1; const bool more = pn >= 0;
                att::NextRef nx{cur.Q, cur.K, cur.V, more ? qn * 256 : cur.P0, more ? (pn & 255) : cur.ja};
                att::attn_block<1>(cur, nx, (char*)lds + RING_OFF, S, F.wave);
                if (!more) break;
                qb = qn; MAKE_REF(cur, qb);
            }
#undef PIECE_OF
#undef MAKE_REF
        }
    }
    xcd_barrier(bar); STAMP();
    }

    for (int rep_ = 0; rep_ < (REP_PHASE == 4 ? 2 : 1); ++rep_) {
    {
        pg8::Gemm g{(const pg8::bf16_t*)Y, (const pg8::bf16_t*)Wout8, M, DM, DM / 2}; pg8::StaticOrder S; S.init(M, DM, F.G, (int)blockIdx.x);
        pg8::EpiResid E{args.x, args.out, PART, DM, 1.f / (W8_SCALE * att::Y8_SCALE)};
        pg8::gemm_phase<pg8::EpiResid, pg8::StaticOrder, true, true, true>(F.lds + RING_OFF, g, S, E, F.wave);
    }
    xcd_barrier(bar); STAMP();
    }

    F.lane = lane_id_asm();
    for (int m = F.vcu * NWAVES + F.wave; m < M; m += NGW) {
        float s = (F.lane < 32) ? PART[(size_t)m * 32 + F.lane] : 0.f;
        s = wave_sum(s);
        const float rstd = 1.f / sqrtf(s * (1.f / DM) + EPS);
        GAS f32x4* xr = (GAS f32x4*)(args.out + (size_t)m * DM) + F.lane; const GAS f32x4* gr = (const GAS f32x4*)args.final_gain + F.lane;
#pragma unroll
        for (int j = 0; j < 8; ++j) { const f32x4 v = xr[64 * j], g = gr[64 * j]; xr[64 * j] = (f32x4){v.x * rstd * g.x, v.y * rstd * g.y, v.z * rstd * g.z, v.w * rstd * g.w}; }
    }

#ifdef DBG_TS
    xcd_barrier(bar); STAMP();
    if (blockIdx.x == 0 && F.tid == 0) args.out[0] += (float)(ts_[DBG_TS] - ts_[DBG_TS - 1]);
#endif
#ifdef DBG_CHECK
    xcd_barrier(bar);
    {
        const size_t TS = (size_t)M * TP;
#if DBG_WHAT == 0
        for (int it = gw; it < M * 16; it += NGW) {
            const int m_ = it >> 4, mode = (it >> 3) & 1, h = it & 7, b = m_ / T, t = m_ % T;
            if (mode != DBG_CHECK) continue;
            const size_t ro = (size_t)b * T * TP + (size_t)h * 128; const int tb = mode * 4;
            const float slope = __builtin_amdgcn_exp2f(-(float)(h + 1));
            const float d = dbg_row(mode, F.lane, PROJ + (tb + 0) * TS + ro, PROJ + (tb + 1) * TS + ro, PROJ + (tb + 2) * TS + ro, PROJ + (tb + 3) * TS + ro,
                                    Y + (size_t)m_ * DM + mode * 1024 + h * 128, MASK + (size_t)b * 64 * T, args.rel_bias + h * NREL, -slope * LOG2E, t);
            if (F.lane == 0) atomicMax((unsigned*)(F.ctl + 8), __float_as_uint(d));
        }
#elif DBG_WHAT == 6
        for (int it = gw; it < 32 * 37 * 64; it += NGW) {
            const int tile = it >> 6, k = it & 63, pm = tile / 37, pn = tile % 37;
            const unsigned hsh = (unsigned)it * 2654435761u; const int m_ = pm * 256 + (hsh >> 8) % 256, n_ = pn * 256 + (hsh >> 20) % 256;
            if (n_ >= D_IN) continue;
            const float* xr = args.x + (size_t)m_ * DM; float ss = 0.f;
            for (int j = 0; j < 32; ++j) { const float v = xr[F.lane + 64 * j]; ss += v * v; }
            const float rstd = 1.f / sqrtf(wave_sum(ss) * (1.f / DM) + EPS); float acc = 0.f;
            for (int j = 0; j < 32; ++j) { const int kk = F.lane + 64 * j; const float hv = __uint_as_float(f2bf(xr[kk] * rstd * args.norm_gain[kk]) << 16);
                acc += hv * __uint_as_float(f2bf(args.w_in[(size_t)kk * D_IN + n_]) << 16); }
            acc = wave_sum(acc);
            const int tt = n_ >> 10; if (tt == 0 || tt == 4) acc *= C2;
            const float got = __uint_as_float((unsigned)PROJ[(size_t)tt * TS + (size_t)m_ * TP + (n_ & 1023)] << 16);
            const float d = fabsf(got - acc) / (fabsf(acc) * 0.01f + 0.02f);
            if (F.lane == 0) atomicMax((unsigned*)(F.ctl + 8), __float_as_uint(d));
        }
#elif DBG_WHAT == 7
        for (int m_ = F.vcu; m_ < M; m_ += 64 * F.G / 64 * 1) { if ((m_ % 61) != 0) continue;
            float z[4]; float ssq = 0.f;
            for (int q = 0; q < 4; ++q) { const int n_ = F.wave * 256 + q * 64 + F.lane; float acc = 0.f;
                for (int kk = 0; kk < DM; ++kk) acc += __uint_as_float((unsigned)Y[(size_t)m_ * DM + kk] << 16) * __uint_as_float(f2bf(args.w_out[(size_t)kk * DM + n_]) << 16);
                z[q] = args.x[(size_t)m_ * DM + n_] + acc; ssq += z[q] * z[q]; }
            ssq = wave_sum(ssq);
            LAS float* red = (LAS float*)(F.lds + RING_OFF);
            __syncthreads(); if (F.lane == 0) red[F.wave] = ssq; __syncthreads();
            float tot = 0.f; for (int w = 0; w < 8; ++w) tot += red[w];
            const float rstd = 1.f / sqrtf(tot * (1.f / DM) + EPS); float d = 0.f;
            for (int q = 0; q < 4; ++q) { const int n_ = F.wave * 256 + q * 64 + F.lane; d = fmaxf(d, fabsf(z[q] * rstd * args.final_gain[n_] - args.out[(size_t)m_ * DM + n_])); }
#pragma unroll
            for (int o = 1; o < 64; o <<= 1) d = fmaxf(d, __shfl_xor(d, o));
            if (F.lane == 0) atomicMax((unsigned*)(F.ctl + 8), __float_as_uint(d));
        }
#endif
    }
    xcd_barrier(bar);
    if (blockIdx.x == 0 && F.tid == 0) {
#if DBG_WHAT == 0 || DBG_WHAT == 6 || DBG_WHAT == 7
        args.out[0] += 10000.f * __uint_as_float(__hip_atomic_load((unsigned*)(F.ctl + 8), __ATOMIC_RELAXED, __HIP_MEMORY_SCOPE_AGENT));
#elif DBG_WHAT == 3
        args.out[0] += 100000.f * __uint_as_float(__hip_atomic_load((unsigned*)(F.ctl + 9), __ATOMIC_RELAXED, __HIP_MEMORY_SCOPE_AGENT));
#elif DBG_WHAT == 4
        args.out[0] += 10.f * (float)__hip_atomic_load((unsigned*)(F.ctl + 10), __ATOMIC_RELAXED, __HIP_MEMORY_SCOPE_AGENT);
#elif DBG_WHAT == 5
        args.out[0] += 10.f * (float)__hip_atomic_load((unsigned*)(F.ctl + 11), __ATOMIC_RELAXED, __HIP_MEMORY_SCOPE_AGENT);
#endif
    }
#endif
}

extern "C" void kernel_launch(void* const* d_in, const int* in_sizes, int n_in, void* d_out, int out_size, void* d_ws, size_t ws_size, hipStream_t stream) {
    static int grid = 0;
    if (grid == 0) {
        if (n_in != 6 || in_sizes[0] != M * DM || in_sizes[2] != DM * D_IN || out_size != M * DM || ws_size < WS_END) {
            fprintf(stderr, "kernel_launch: unexpected shapes / workspace (n_in %d, ws %zu); nothing launched\n", n_in, ws_size); grid = -1; return; }
        int dev = 0, cus = 0;
        if (hipGetDevice(&dev) != hipSuccess || hipDeviceGetAttribute(&cus, hipDeviceAttributeMultiprocessorCount, dev) != hipSuccess) { grid = -1; return; }
        if (hipFuncSetAttribute((const void*)skel_fwd, hipFuncAttributeMaxDynamicSharedMemorySize, LDS_BYTES) != hipSuccess) { fprintf(stderr, "kernel_launch: hipFuncSetAttribute failed\n"); grid = -1; return; }
        (void)hipGetLastError();
        grid = cus < 256 ? cus : 256;
    }
    if (grid < 0) return;
    if (hipMemsetAsync((char*)d_ws + WS_CTL, 0, CTL_ZERO_BYTES, stream) != hipSuccess) return;
    Args a{};
    a.x = (const float*)d_in[0]; a.norm_gain = (const float*)d_in[1]; a.w_in = (const float*)d_in[2]; a.rel_bias = (const float*)d_in[3];
    a.w_out = (const float*)d_in[4]; a.final_gain = (const float*)d_in[5]; a.out = (float*)d_out; a.ws = (unsigned char*)d_ws;
    hipLaunchKernelGGL(skel_fwd, dim3(grid), dim3(NWAVES * 64), LDS_BYTES, stream, a);
}
```

```cpp
#include <hip/hip_runtime.h>
#include <hip/hip_bf16.h>
#include <cstdio>
#include <cstdint>
namespace pg8 {
#define PG8_LAS __attribute__((address_space(3)))
typedef unsigned short bf16_t;
typedef short bf16x8 __attribute__((ext_vector_type(8)));
typedef float f32x4 __attribute__((ext_vector_type(4)));
typedef unsigned u32x4 __attribute__((ext_vector_type(4)));
typedef int i32x4 __attribute__((ext_vector_type(4)));
typedef int i32x8 __attribute__((ext_vector_type(8)));
constexpr int BM = 256, BK = 64, HALF = 128, HTB = HALF * BK * 2  , STAGE_BYTES = 8 * HTB, NXCD = 8, WGM = 8;

__host__ __device__ __forceinline__ int lds_byte(int r, int c) { const int st = (r >> 4) * 2 + (c >> 5), rr = r & 15, cc = c & 31, ob = rr * 64 + cc * 2; return st * 1024 + (ob ^ (((ob >> 9) & 1) << 5)); }
__host__ __device__ __forceinline__ void stage_rc(int b, int& R, int& C) { const int st = b / 1024, sb = b % 1024, swz = sb ^ (((sb >> 9) & 1) << 5); R = (st >> 1) * 16 + swz / 64; C = (st & 1) * 32 + (swz % 64) / 2; }
__host__ __device__ __forceinline__ int perm32(int rho) { const int n = rho >> 4, i = rho & 15; return 8 * (i >> 2) + 4 * n + (i & 3); }

struct Unit { int pm, pn; };
struct Gemm { const bf16_t* A; const bf16_t* Bt; int M, N, K; };

struct StaticOrder {
    int nM, nN, nwg, G, c;
    __host__ __device__ void init(int M, int N, int G_, int c_) { nM = M / BM; nN = N / BM; nwg = nM * nN; G = G_; c = c_; }
    __host__ __device__ bool next(int i, Unit& u) const {
        const long L = (long)i * G + c; if (L >= nwg) return false;
        int wgid = (int)L; { const int q = nwg / NXCD, r = nwg % NXCD, xcd = wgid % NXCD, off = wgid / NXCD; wgid = (xcd < r ? xcd * (q + 1) : r * (q + 1) + (xcd - r) * q) + off; }
        const int nig = WGM * nN, gid = wgid / nig, fm = gid * WGM, gsz = (nM - fm) < WGM ? (nM - fm) : WGM;
        u.pm = fm + ((wgid % nig) % gsz); u.pn = (wgid % nig) / gsz; return true;
    }
    __device__ __forceinline__ void a_ready(const Unit&) const {}
    __device__ __forceinline__ void done(const Unit&) const {}
};

__device__ __forceinline__ unsigned cvt_pk_bf16(float lo, float hi) { unsigned r; asm volatile("v_cvt_pk_bf16_f32 %0, %1, %2" : "=v"(r) : "v"(lo), "v"(hi)); return r; }

struct EpiSplit {
    static constexpr bool PERM = true, AFTER_DRAIN = false;
    bf16_t* O; int ldc; int split_cols; size_t split_stride; float scale0; float scale; int col_base;
    __device__ __forceinline__ void operator()(const f32x4 (&acc)[2][2][4][2], const Unit& u, int wr, int wc, int fr, int fq) const {
        const int row0 = u.pm * BM + wr * 64 + fr; int colt = u.pn * BM + col_base; bf16_t* base = O;
        float sc = scale; { const int t = colt / split_cols; base += (size_t)t * split_stride; colt -= t * split_cols; if (t == 0 || t == 4) sc *= scale0; }
        const int col0 = colt + wc * 32 + 8 * fq;
#pragma unroll
        for (int ai = 0; ai < 2; ++ai)
#pragma unroll
            for (int m = 0; m < 4; ++m) { bf16_t* rowp = base + (size_t)(row0 + ai * HALF + m * 16) * ldc + col0;
#pragma unroll
                for (int bj = 0; bj < 2; ++bj) { f32x4 v0 = acc[ai][bj][m][0] * sc, v1 = acc[ai][bj][m][1] * sc;
                    u32x4 w; w.x = cvt_pk_bf16(v0[0], v0[1]); w.y = cvt_pk_bf16(v0[2], v0[3]); w.z = cvt_pk_bf16(v1[0], v1[1]); w.w = cvt_pk_bf16(v1[2], v1[3]);
                    *(u32x4*)(rowp + bj * HALF) = w; } }
    }
};
struct EpiResid {
    static constexpr bool PERM = false, AFTER_DRAIN = false;
    const float* base; float* out; float* part; int ldc; float scale;
    __device__ __forceinline__ void operator()(const f32x4 (&acc)[2][2][4][2], const Unit& u, int wr, int wc, int fr, int fq) const {
        const int col0 = u.pn * BM + wc * 32 + 4 * fq;
#pragma unroll
        for (int ai = 0; ai < 2; ++ai)
#pragma unroll
            for (int m = 0; m < 4; ++m) { const int r = u.pm * BM + ai * HALF + wr * 64 + m * 16 + fr; const size_t off = (size_t)r * ldc + col0; float ss = 0.f;
#pragma unroll
                for (int bj = 0; bj < 2; ++bj)
#pragma unroll
                    for (int n = 0; n < 2; ++n) { const f32x4 bs = *(const f32x4*)(base + off + bj * HALF + n * 16); const f32x4 o = bs + acc[ai][bj][m][n] * scale;
                        *(f32x4*)(out + off + bj * HALF + n * 16) = o; ss += (o[0] * o[0] + o[1] * o[1]) + (o[2] * o[2] + o[3] * o[3]); }
                ss += __shfl_xor(ss, 16); ss += __shfl_xor(ss, 32);
                if (fq == 0) part[(size_t)r * 32 + u.pn * 4 + wc] = ss; }
    }
};

template <class Epi, class Sched, bool ALIGN_EPI = false, bool SP2 = false, bool FP8 = false>
__device__ __forceinline__ void gemm_phase(PG8_LAS unsigned char* lds, const Gemm g, const Sched& S, const Epi& E, int wave_) {
    int tid_; asm volatile("v_mbcnt_lo_u32_b32 %0, -1, 0\n\tv_mbcnt_hi_u32_b32 %0, -1, %0\n\tv_lshl_add_u32 %0, %1, 6, %0" : "=&v"(tid_) : "s"(wave_)); const int tid = tid_, wid = __builtin_amdgcn_readfirstlane(tid >> 6), lane = tid & 63, wr = wid >> 2, wc = wid & 3, fr = lane & 15, fq = lane >> 4;
    const int K = g.K, nt = K / BK;
    unsigned voffA[2], voffB[2];
#pragma unroll
    for (int i = 0; i < 2; ++i) { int R, C; stage_rc(tid * 16 + i * 8192, R, C); const int Rb = Epi::PERM ? ((R & ~31) + perm32(R & 31)) : R;
        voffA[i] = (unsigned)(R * K + C) * 2u; voffB[i] = (unsigned)(Rb * K + C) * 2u; }
    const size_t kstep = (size_t)(BK * 2);
    const size_t hstep = (size_t)HALF * K * 2;
    const size_t tstep = 2 * hstep;
    const unsigned ldsw = (unsigned)wid * 1024u;
    const int aoff = lds_byte(wr * 64 + fr, fq * 8), boff = lds_byte(wc * 32 + fr, fq * 8);
#define PG8_SA(b, h) (((b) * 2 + (h)) * HTB)
#define PG8_SB(b, h) ((4 + (b) * 2 + (h)) * HTB)
#define PG8_STAGE(bufoff, gbase, voff) do { _Pragma("unroll") for (int _i = 0; _i < 2; ++_i) \
        __builtin_amdgcn_global_load_lds((const unsigned*)((const char*)(gbase) + (voff)[_i]), (PG8_LAS unsigned*)(lds + (bufoff) + ldsw + _i * 8192), 16, 0, 0); } while (0)
#define PG8_LDA(dst, b, h) do { _Pragma("unroll") for (int m = 0; m < 4; ++m) _Pragma("unroll") for (int k = 0; k < 2; ++k) dst[m][k] = *(const PG8_LAS bf16x8*)(lds + PG8_SA(b, h) + aoff + m * 2048 + k * 1024); } while (0)
#define PG8_LDB(dst, b, h) do { _Pragma("unroll") for (int n = 0; n < 2; ++n) _Pragma("unroll") for (int k = 0; k < 2; ++k) dst[n][k] = *(const PG8_LAS bf16x8*)(lds + PG8_SB(b, h) + boff + n * 2048 + k * 1024); } while (0)
#define PG8_MMA(ai, bj, At, Bt) do { __builtin_amdgcn_s_setprio(1); _Pragma("unroll") for (int m = 0; m < 4; ++m) _Pragma("unroll") for (int n = 0; n < 2; ++n) { \
        if constexpr (FP8) {   \
            const i32x8 b8_ = __builtin_shufflevector(__builtin_bit_cast(i32x4, Bt[n][0]), __builtin_bit_cast(i32x4, Bt[n][1]), 0, 1, 2, 3, 4, 5, 6, 7); \
            const i32x8 a8_ = __builtin_shufflevector(__builtin_bit_cast(i32x4, At[m][0]), __builtin_bit_cast(i32x4, At[m][1]), 0, 1, 2, 3, 4, 5, 6, 7); \
            asm volatile("v_mfma_f32_16x16x128_f8f6f4 %0, %1, %2, %0" : "+v"(acc[ai][bj][m][n]) : "v"(b8_), "v"(a8_));   \
        } else { _Pragma("unroll") for (int k = 0; k < 2; ++k) \
            acc[ai][bj][m][n] = __builtin_amdgcn_mfma_f32_16x16x32_bf16(Bt[n][k], At[m][k], acc[ai][bj][m][n], 0, 0, 0); } } __builtin_amdgcn_s_setprio(0); } while (0)
#define PG8_WAIT_V(n) asm volatile("s_waitcnt vmcnt(" #n ")" ::: "memory")
#define PG8_WAIT_L(n) asm volatile("s_waitcnt lgkmcnt(" #n ")" ::: "memory")
#define PG8_BAR __builtin_amdgcn_s_barrier()
#define PG8_SCHED __builtin_amdgcn_sched_barrier(0)
    Unit cur, nxt; int ui = 0;
    if (!S.next(0, cur)) return;
    f32x4 acc[2][2][4][2];
#pragma unroll
    for (int a = 0; a < 2; ++a)
#pragma unroll
        for (int b = 0; b < 2; ++b)
#pragma unroll
            for (int m = 0; m < 4; ++m)
#pragma unroll
                for (int n = 0; n < 2; ++n) acc[a][b][m][n] = (f32x4){0.f, 0.f, 0.f, 0.f};
    bf16x8 At[4][2], B0[2][2], B1[2][2];
    const char* cA = (const char*)g.A + (size_t)cur.pm * tstep; const char* cB = (const char*)g.Bt + (size_t)cur.pn * tstep;
    S.a_ready(cur);
    if constexpr (SP2) {
        PG8_STAGE(PG8_SB(0, 0), cB, voffB); PG8_STAGE(PG8_SB(0, 1), cB + hstep, voffB); PG8_STAGE(PG8_SA(0, 0), cA, voffA); PG8_STAGE(PG8_SA(0, 1), cA + hstep, voffA);
        if (wr == 1) PG8_BAR;
        PG8_WAIT_V(2); PG8_BAR;
        PG8_STAGE(PG8_SB(1, 0), cB + kstep, voffB); PG8_STAGE(PG8_SA(1, 0), cA + kstep, voffA); PG8_STAGE(PG8_SB(1, 1), cB + hstep + kstep, voffB);
        PG8_WAIT_V(6); PG8_BAR;
    } else {
        PG8_STAGE(PG8_SB(0, 0), cB, voffB); PG8_STAGE(PG8_SA(0, 0), cA, voffA); PG8_STAGE(PG8_SB(0, 1), cB + hstep, voffB); PG8_STAGE(PG8_SA(0, 1), cA + hstep, voffA);
        if (wr == 1) PG8_BAR;
        PG8_WAIT_V(4); PG8_BAR;
        PG8_STAGE(PG8_SB(1, 0), cB + kstep, voffB); PG8_STAGE(PG8_SA(1, 0), cA + kstep, voffA); PG8_STAGE(PG8_SB(1, 1), cB + hstep + kstep, voffB);
        PG8_WAIT_V(6); PG8_BAR;
    }
    for (;;) {
        const bool has_next = S.next(ui + 1, nxt);
        const char* nA = has_next ? (const char*)g.A + (size_t)nxt.pm * tstep : cA; const char* nB = has_next ? (const char*)g.Bt + (size_t)nxt.pn * tstep : cB;
        for (int t = 0; t < nt; t += 2) {
            const bool last = (t == nt - 2);
            const char* a1 = cA + (size_t)(t + 1) * kstep;
            const char* a2 = last ? nA : cA + (size_t)(t + 2) * kstep; const char* b2 = last ? nB : cB + (size_t)(t + 2) * kstep;
            const char* a3 = a2 + kstep; const char* b3 = b2 + kstep;
            if (last && has_next) S.a_ready(nxt);
            if constexpr (SP2) {
            PG8_LDB(B0, 0, 0); PG8_LDB(B1, 0, 1); PG8_SCHED; PG8_LDA(At, 0, 0); PG8_STAGE(PG8_SA(1, 1), a1 + hstep, voffA);
            PG8_WAIT_V(8); PG8_WAIT_L(0); PG8_BAR; PG8_MMA(0, 0, At, B0); PG8_MMA(0, 1, At, B1); PG8_BAR; PG8_SCHED;
            PG8_LDA(At, 0, 1); PG8_STAGE(PG8_SB(0, 0), b2, voffB); PG8_STAGE(PG8_SB(0, 1), b2 + hstep, voffB); PG8_STAGE(PG8_SA(0, 0), a2, voffA);
            PG8_WAIT_V(8); PG8_WAIT_L(0); PG8_BAR; PG8_MMA(1, 0, At, B0); PG8_MMA(1, 1, At, B1); PG8_BAR; PG8_SCHED;
            PG8_LDB(B0, 1, 0); PG8_LDB(B1, 1, 1); PG8_SCHED; PG8_LDA(At, 1, 0); PG8_STAGE(PG8_SA(0, 1), a2 + hstep, voffA);
            PG8_WAIT_V(8); PG8_WAIT_L(0); PG8_BAR; PG8_MMA(0, 0, At, B0); PG8_MMA(0, 1, At, B1); PG8_BAR; PG8_SCHED;
            PG8_LDA(At, 1, 1); PG8_STAGE(PG8_SB(1, 0), b3, voffB); PG8_STAGE(PG8_SB(1, 1), b3 + hstep, voffB); PG8_STAGE(PG8_SA(1, 0), a3, voffA);
            PG8_WAIT_V(8); PG8_WAIT_L(0); PG8_BAR; PG8_MMA(1, 0, At, B0); PG8_MMA(1, 1, At, B1); PG8_BAR; PG8_SCHED;
            } else {
            PG8_LDB(B0, 0, 0); PG8_SCHED; PG8_LDA(At, 0, 0); PG8_STAGE(PG8_SA(1, 1), a1 + hstep, voffA);
            PG8_WAIT_L(8); PG8_BAR; PG8_WAIT_L(0); PG8_MMA(0, 0, At, B0); PG8_BAR; PG8_SCHED;
            PG8_LDB(B1, 0, 1); PG8_STAGE(PG8_SB(0, 0), b2, voffB);
            PG8_BAR; PG8_WAIT_L(0); PG8_MMA(0, 1, At, B1); PG8_BAR;
            PG8_LDA(At, 0, 1); PG8_STAGE(PG8_SA(0, 0), a2, voffA);
            PG8_BAR; PG8_WAIT_L(0); PG8_MMA(1, 0, At, B0); PG8_BAR; PG8_SCHED;
            PG8_STAGE(PG8_SB(0, 1), b2 + hstep, voffB);
            PG8_WAIT_V(6); PG8_BAR; PG8_MMA(1, 1, At, B1); PG8_BAR;
            PG8_LDB(B0, 1, 0); PG8_SCHED; PG8_LDA(At, 1, 0); PG8_STAGE(PG8_SA(0, 1), a2 + hstep, voffA);
            PG8_WAIT_L(8); PG8_BAR; PG8_WAIT_L(0); PG8_MMA(0, 0, At, B0); PG8_BAR; PG8_SCHED;
            PG8_LDB(B1, 1, 1); PG8_STAGE(PG8_SB(1, 0), b3, voffB);
            PG8_BAR; PG8_WAIT_L(0); PG8_MMA(0, 1, At, B1); PG8_BAR;
            PG8_LDA(At, 1, 1); PG8_STAGE(PG8_SA(1, 0), a3, voffA);
            PG8_BAR; PG8_WAIT_L(0); PG8_MMA(1, 0, At, B0); PG8_BAR; PG8_SCHED;
            PG8_STAGE(PG8_SB(1, 1), b3 + hstep, voffB);
            PG8_WAIT_V(6); PG8_BAR; PG8_MMA(1, 1, At, B1); PG8_BAR;
            }
        }
        if constexpr (ALIGN_EPI) { if (wr == 0) PG8_BAR; }
        if constexpr (FP8) asm volatile("s_nop 15\n\ts_nop 15" ::: "memory");
        if constexpr (!Epi::AFTER_DRAIN) { E(acc, cur, wr, wc, fr, fq); S.done(cur); }
        if (!has_next) break;
#pragma unroll
        for (int a = 0; a < 2; ++a)
#pragma unroll
            for (int b = 0; b < 2; ++b)
#pragma unroll
                for (int m = 0; m < 4; ++m)
#pragma unroll
                    for (int n = 0; n < 2; ++n) acc[a][b][m][n] = (f32x4){0.f, 0.f, 0.f, 0.f};
        cur = nxt; cA = nA; cB = nB; ++ui;
        if constexpr (ALIGN_EPI) { if (wr == 1) PG8_BAR; }
    }
    PG8_WAIT_V(0);
    if constexpr (!ALIGN_EPI) { if (wr == 0) PG8_BAR; }
    PG8_BAR;
    if constexpr (Epi::AFTER_DRAIN) { E.fused(acc, cur, wr, wc, fr, fq, lds, wid, lane); S.done(cur); }
#undef PG8_SA
#undef PG8_SB
#undef PG8_STAGE
#undef PG8_LDA
#undef PG8_LDB
#undef PG8_MMA
#undef PG8_WAIT_V
#undef PG8_WAIT_L
#undef PG8_BAR
#undef PG8_SCHED
}
}
namespace att {
typedef unsigned short u16;
typedef short bf16x8 __attribute__((ext_vector_type(8)));
typedef short s16x4 __attribute__((ext_vector_type(4)));
typedef float f32x16 __attribute__((ext_vector_type(16)));
typedef float f32x4 __attribute__((ext_vector_type(4)));
typedef unsigned u32x4 __attribute__((ext_vector_type(4)));
typedef unsigned u32x2 __attribute__((ext_vector_type(2)));
constexpr int D = 128, NW = 8, QBLK = 32, KVBLK = 64, QB = NW * QBLK;
constexpr int PITCH = 1024;
constexpr int YPITCH = 2048;
constexpr float Y8_SCALE = 16.f;
constexpr int SEQ = 4096;
constexpr int SHM_V = KVBLK * D * 2, SHM_K = KVBLK * D * 2;
constexpr int LDS_WS = 2 * SHM_V + 2 * SHM_K;
constexpr int LDS_BT = LDS_WS + NW * 64 * 4;
constexpr int LDS_MT = LDS_BT + 1280;
constexpr int LDS_BYTES = LDS_MT + NW * 96 * 4;
constexpr float THR = 8.f;

#define KSWZ(row, colB) ((row) * 256 + ((colB) ^ (((row) & 7) << 4)))
#define SBAR() __builtin_amdgcn_sched_barrier(0)
__device__ __forceinline__ int v_st(int k, int c) { const int kk = (k & ~0xC) | ((k & 4) << 1) | ((k & 8) >> 1); return ((kk >> 3) * 4 + (c >> 5)) * 512 + ((kk & 7) * 32 + (c & 31)) * 2; }
__device__ __forceinline__ int v_rd_base(int lane) { return ((lane & 3) << 3) | (((lane >> 2) & 3) << 6) | (((lane >> 4) & 1) << 5) | (((lane >> 5) & 1) << 8); }
constexpr int v_rd_off(int d0, int ks, int half) { return d0 * 512 + ks * 4096 + half * 2048; }
__device__ __forceinline__ int crow(int r, int hi) { return (r & 3) + 8 * (r >> 2) + 4 * hi; }
__device__ __forceinline__ unsigned cvtpk(float lo, float hi) { unsigned r; asm volatile("v_cvt_pk_bf16_f32 %0, %1, %2" : "=v"(r) : "v"(lo), "v"(hi)); return r; }
__device__ __forceinline__ bf16x8 load8(const u16* p) { return *reinterpret_cast<const bf16x8*>(p); }
__device__ __forceinline__ float bf2f(unsigned h) { return __uint_as_float(h << 16); }

__device__ __forceinline__ void partialSM(f32x16& p0, f32x16& p1, float& m_reg, float& alpha) {
    float pmax = p0[0];
#pragma unroll
    for (int r = 1; r < 16; ++r) pmax = fmaxf(pmax, p0[r]);
#pragma unroll
    for (int r = 0; r < 16; ++r) pmax = fmaxf(pmax, p1[r]);
    { auto rr = __builtin_amdgcn_permlane32_swap(__float_as_uint(pmax), __float_as_uint(pmax), false, false);
      pmax = fmaxf(__uint_as_float(rr[0]), __uint_as_float(rr[1])); }
    float mn;
    if (__builtin_expect(__all((pmax - m_reg) <= THR), 1)) { mn = m_reg; alpha = 1.f; }
    else { mn = fmaxf(m_reg, pmax); alpha = __builtin_amdgcn_exp2f(m_reg - mn); m_reg = mn; }
#pragma unroll
    for (int r = 0; r < 16; ++r) p0[r] = p0[r] - mn;
#pragma unroll
    for (int r = 0; r < 16; ++r) p1[r] = p1[r] - mn;
#pragma unroll
    for (int r = 0; r < 16; ++r) p0[r] = __builtin_amdgcn_exp2f(p0[r]);
}
__device__ __forceinline__ void finishSM(f32x16& p0, f32x16& p1, float alpha, float& l_reg, bf16x8& pa0, bf16x8& pa1, bf16x8& pa2, bf16x8& pa3) {
#pragma unroll
    for (int r = 0; r < 16; ++r) p1[r] = __builtin_amdgcn_exp2f(p1[r]);
    float ps = 0;
#pragma unroll
    for (int r = 0; r < 16; ++r) ps += p0[r];
#pragma unroll
    for (int r = 0; r < 16; ++r) ps += p1[r];
    { auto rr = __builtin_amdgcn_permlane32_swap(__float_as_uint(ps), __float_as_uint(ps), false, false);
      ps = __uint_as_float(rr[0]) + __uint_as_float(rr[1]); }
    l_reg = l_reg * alpha + ps;
#define PK4(P, B_, OUT) do { unsigned a0 = cvtpk(P[B_+0], P[B_+1]), a1 = cvtpk(P[B_+2], P[B_+3]);                          \
        unsigned b0 = cvtpk(P[B_+4], P[B_+5]), b1 = cvtpk(P[B_+6], P[B_+7]);                                             \
        auto r0 = __builtin_amdgcn_permlane32_swap(a0, b0, false, false); auto r1 = __builtin_amdgcn_permlane32_swap(a1, b1, false, false); \
        u32x4 w = {r0[0], r1[0], r0[1], r1[1]}; OUT = *reinterpret_cast<bf16x8*>(&w); } while (0)
    PK4(p0, 0, pa0); PK4(p0, 8, pa1); PK4(p1, 0, pa2); PK4(p1, 8, pa3);
#undef PK4
}
template <int KB>
__device__ __forceinline__ void qkt(f32x16& p0, f32x16& p1, const char* K_lds, int r32, int hi, const bf16x8* qr, bool act) {
    if (!act) { const float NEG = -__builtin_inff();
#pragma unroll
        for (int r = 0; r < 16; ++r) { p0[r] = NEG; p1[r] = NEG; } return; }
    p0 = f32x16{}; p1 = f32x16{};
    const char* kb[4];
#pragma unroll
    for (int dd = 0; dd < 4; ++dd) kb[dd] = K_lds + KB * SHM_K + KSWZ(r32, (dd * 16 + hi * 8) * 2);
#pragma unroll
    for (int d0 = 0; d0 < 8; ++d0) { const char* a = kb[d0 & 3] + (d0 >> 2) * 128;
        bf16x8 b0 = *reinterpret_cast<const bf16x8*>(a);
        bf16x8 b1 = *reinterpret_cast<const bf16x8*>(a + 32 * 256);
        p0 = __builtin_amdgcn_mfma_f32_32x32x16_bf16(b0, qr[d0], p0, 0, 0, 0);
        p1 = __builtin_amdgcn_mfma_f32_32x32x16_bf16(b1, qr[d0], p1, 0, 0, 0); }
}
template <int VB>
__device__ __forceinline__ void pv_tile(f32x16* o, int vb0, bf16x8 pa0, bf16x8 pa1, bf16x8 pa2, bf16x8 pa3, bool act) {
    if (!act) return;
#define TRRD(dst, off) asm volatile("ds_read_b64_tr_b16 %0, %1 offset:%2" : "=&v"(dst) : "v"(vb0), "i"(off) : "memory")
#define PV_D0(d0) do { s16x4 l0, l1, l2, l3, h0, h1, h2, h3; constexpr int b_ = VB * SHM_V + v_rd_off(d0, 0, 0); \
        TRRD(l0, b_); TRRD(h0, b_ + 2048); TRRD(l1, b_ + 4096); TRRD(h1, b_ + 6144); TRRD(l2, b_ + 8192); TRRD(h2, b_ + 10240); TRRD(l3, b_ + 12288); TRRD(h3, b_ + 14336); \
        asm volatile("s_waitcnt lgkmcnt(0)" ::: "memory"); SBAR(); \
        o[d0] = __builtin_amdgcn_mfma_f32_32x32x16_bf16(pa0, (bf16x8){l0[0], l0[1], l0[2], l0[3], h0[0], h0[1], h0[2], h0[3]}, o[d0], 0, 0, 0);   \
        o[d0] = __builtin_amdgcn_mfma_f32_32x32x16_bf16(pa1, (bf16x8){l1[0], l1[1], l1[2], l1[3], h1[0], h1[1], h1[2], h1[3]}, o[d0], 0, 0, 0);   \
        o[d0] = __builtin_amdgcn_mfma_f32_32x32x16_bf16(pa2, (bf16x8){l2[0], l2[1], l2[2], l2[3], h2[0], h2[1], h2[2], h2[3]}, o[d0], 0, 0, 0);   \
        o[d0] = __builtin_amdgcn_mfma_f32_32x32x16_bf16(pa3, (bf16x8){l3[0], l3[1], l3[2], l3[3], h3[0], h3[1], h3[2], h3[3]}, o[d0], 0, 0, 0); } while (0)
    PV_D0(0); PV_D0(1); PV_D0(2); PV_D0(3);
#undef PV_D0
#undef TRRD
}

struct BlockRef { const u16* Q; const u16* K; const u16* V; const u16* G; unsigned char* Y; const unsigned long long* M; int P0; float nslope;
    int ja, jb;
    int role;
    float* slab; unsigned* flag; int nother; int dry; };
constexpr int SLAB_FLOATS = 8 * 64 * 64 + 8 * 128;
constexpr int FLAG_STRIDE = 64;
struct NextRef { const u16* Q; const u16* K; const u16* V; int P0; int ja; };
struct Seam { bf16x8 qr[8]; bf16x8 st_v0, st_v1, st_k0, st_k1; };
#define ROW(p, k0, rr) ((p) + (size_t)((k0) + (rr)) * PITCH + sc)
#define VMW() asm volatile("s_waitcnt vmcnt(0)" ::: "memory")
#define VMWN(n) asm volatile("s_waitcnt vmcnt(%0)" :: "i"(n) : "memory")
#define SLOAD_H(Kp, Vp, k0) do { S.st_v0 = load8(ROW(Vp, k0, sr)); S.st_v1 = load8(ROW(Vp, k0, 32 + sr));              \
                         S.st_k0 = load8(ROW(Kp, k0, sr)); S.st_k1 = load8(ROW(Kp, k0, 32 + sr)); } while (0)
#define SWRITE_HK(bf) do { *(bf16x8*)(K_lds + (bf) * SHM_K + kws) = S.st_k0; *(bf16x8*)(K_lds + (bf) * SHM_K + kws + 32 * 256) = S.st_k1; } while (0)
#define SWRITE_HV(bf) do { *(bf16x8*)(V_lds + (bf) * SHM_V + vst0) = S.st_v0; *(bf16x8*)(V_lds + (bf) * SHM_V + vst1) = S.st_v1; } while (0)
#define SWRITE_H(bf) do { SWRITE_HV(bf); SWRITE_HK(bf); } while (0)
template <int MODE>
__device__ __forceinline__ void attn_prime(const BlockRef& cur, char* lds, Seam& S, int wave_) {
    int tid_; asm volatile("v_mbcnt_lo_u32_b32 %0, -1, 0\n\tv_mbcnt_hi_u32_b32 %0, -1, %0\n\tv_lshl_add_u32 %0, %1, 6, %0" : "=&v"(tid_) : "s"(wave_)); const int tid = tid_, wid = __builtin_amdgcn_readfirstlane(tid >> 6), lane = tid & 63, r32 = lane & 31, hi = lane >> 5;
    const int sr = tid >> 4, sc = (tid & 15) * 8, kws = KSWZ(sr, sc * 2); char* K_lds = lds + 2 * SHM_V;
    const int kb0 = cur.ja * KVBLK;
#pragma unroll
    for (int d0 = 0; d0 < 8; ++d0) S.qr[d0] = load8(cur.Q + (size_t)(cur.P0 + wid * QBLK + r32) * PITCH + d0 * 16 + hi * 8);
    SLOAD_H(cur.K, cur.V, kb0); VMW(); SWRITE_HK(0);
    __syncthreads();
}
template <int MODE>
__device__ __forceinline__ void modify(f32x16& p0, f32x16& p1, int jt, int cw, int qpos, int hi, const float* bt, float nslope, u32x2 mw) {
    const int rel0 = qpos - jt * KVBLK - 4 * hi;
    if (MODE == 0) {
        if (jt <= cw - 3) { const float cb = bt[256];
#pragma unroll
            for (int r = 0; r < 16; ++r) { p0[r] += cb; p1[r] += cb; } }
        else {
#pragma unroll
            for (int r = 0; r < 16; ++r) { const int c = (r & 3) + 8 * (r >> 2);
                int i0 = rel0 - c, i1 = rel0 - c - 32;
                i0 = i0 < -128 ? -128 : (i0 > 128 ? 128 : i0); i1 = i1 < -128 ? -128 : (i1 > 128 ? 128 : i1);
                p0[r] += bt[i0 + 128]; p1[r] += bt[i1 + 128]; } }
    } else {
        const float NEG = -__builtin_inff();
        const float fq = (float)rel0;
        const unsigned w0 = mw.x >> (4 * hi), w1 = mw.y >> (4 * hi);
#pragma unroll
        for (int r = 0; r < 16; ++r) { const int c = (r & 3) + 8 * (r >> 2);
            const float t0 = fq - (float)c, t1 = fq - (float)(c + 32);
            float a0 = fmaf(fabsf(t0), nslope, p0[r]), a1 = fmaf(fabsf(t1), nslope, p1[r]);
            p0[r] = ((w0 >> c) & 1u) ? a0 : NEG; p1[r] = ((w1 >> c) & 1u) ? a1 : NEG; }
    }
}
template <int MODE>
__device__ __forceinline__ void attn_block(const BlockRef& cur, const NextRef& nxt, char* lds, Seam& S, int wave_) {
    int tid_; asm volatile("v_mbcnt_lo_u32_b32 %0, -1, 0\n\tv_mbcnt_hi_u32_b32 %0, -1, %0\n\tv_lshl_add_u32 %0, %1, 6, %0" : "=&v"(tid_) : "s"(wave_)); const int tid = tid_, wid = __builtin_amdgcn_readfirstlane(tid >> 6), lane = tid & 63, r32 = lane & 31, hi = lane >> 5;
    const int j_lo = cur.ja;
    const int NT = cur.jb - cur.ja;
    const int kbn = nxt.ja * KVBLK;
    const int cw = cur.P0 / KVBLK + (wid >> 1);
    const int qpos = cur.P0 + wid * QBLK + r32;
    char* V_lds = lds; char* K_lds = lds + 2 * SHM_V;
    float* ws = (float*)(lds + LDS_WS) + wid * 64; float* li_l = ws, * al_l = ws + 32;
    const float* bt = (const float*)(lds + LDS_BT);
    float m_reg = -1e30f, l_reg = 0; f32x16 o[4] = {};
    const int sr = tid >> 4, sc = (tid & 15) * 8, vst0 = v_st(sr, sc), vst1 = v_st(32 + sr, sc), kws = KSWZ(sr, sc * 2);
    const int vb0 = (int)(uintptr_t)V_lds + v_rd_base(lane);
    const u16* Kh = cur.K; const u16* Vh = cur.V;
    const unsigned long long* mrow = cur.M + qpos;
#define RESC(a) do { if (__any((a) < 1.f)) { if (hi == 0) al_l[r32] = (a); asm volatile("s_waitcnt lgkmcnt(0)" ::: "memory");              \
                     for (int d_ = 0; d_ < 4; ++d_) for (int r = 0; r < 16; ++r) o[d_][r] *= al_l[crow(r, hi)]; } } while (0)
#define KBASE(t) (((cur.dry & 1) ? 0 : (j_lo + (t))) * KVBLK)
#define ACT(t) (MODE == 0 ? ((j_lo + (t)) <= cw && (j_lo + (t)) >= cw - 8) : ((j_lo + (t)) <= cw))
#define MLOAD(t) ((MODE == 1 && ACT(t)) ? *(const u32x2*)(mrow + (size_t)((cur.dry & 2) ? 0 : (j_lo + (t))) * SEQ) : (u32x2){0u, 0u})
#define MODT(P0_, P1_, t, MW) do { if (ACT(t)) modify<MODE>(P0_, P1_, j_lo + (t), cw, qpos, hi, bt, cur.nslope, MW); } while (0)
#define SEAM_K0() do { VMWN(8); SWRITE_HK(0); SBAR(); } while (0)
    f32x16 pA0, pA1, pB0, pB1; float alA, alB; bf16x8 pa0, pa1, pa2, pa3; u32x2 mwA, mwB;
    SWRITE_HV(0); SBAR();
    mwA = MLOAD(0);
    if (NT > 1) { SLOAD_H(Kh, Vh, KBASE(1)); }
    SBAR(); qkt<0>(pA0, pA1, K_lds, r32, hi, S.qr, ACT(0));
    MODT(pA0, pA1, 0, mwA); partialSM(pA0, pA1, m_reg, alA);
    if (NT > 1) { VMW(); SWRITE_H(1); }
    __syncthreads();
#define HALF_STEP(PX0, PX1, alX, mwX, PY0, PY1, alY, t, KB, VB, SB) do {                                                      \
        SBAR(); mwX = MLOAD(t); qkt<KB>(PX0, PX1, K_lds, r32, hi, S.qr, ACT(t));                                             \
        finishSM(PY0, PY1, alY, l_reg, pa0, pa1, pa2, pa3); SBAR();                                                           \
        if ((t) + 1 < NT) { SLOAD_H(Kh, Vh, KBASE((t) + 1)); SBAR(); }                                                        \
        pv_tile<VB>(o, vb0, pa0, pa1, pa2, pa3, ACT((t) - 1)); MODT(PX0, PX1, (t), mwX); partialSM(PX0, PX1, m_reg, alX);    \
        __syncthreads();                                                                                                      \
        if ((t) + 1 < NT) { VMW(); SWRITE_H(SB); }                                                                            \
        RESC(alX); __syncthreads(); } while (0)
    for (int t = 1; t + 1 < NT; t += 2) {
        HALF_STEP(pB0, pB1, alB, mwB, pA0, pA1, alA, t, 1, 0, 0);
        HALF_STEP(pA0, pA1, alA, mwA, pB0, pB1, alB, t + 1, 0, 1, 1);
    }
    const bool even = (NT & 1) == 0;
    if (even) { SBAR(); mwB = MLOAD(NT - 1); qkt<1>(pB0, pB1, K_lds, r32, hi, S.qr, ACT(NT - 1)); SBAR(); }
    SLOAD_H(nxt.K, nxt.V, kbn); SBAR();
#pragma unroll
    for (int d0 = 0; d0 < 8; ++d0) S.qr[d0] = load8(nxt.Q + (size_t)(nxt.P0 + wid * QBLK + r32) * PITCH + d0 * 16 + hi * 8);
    SBAR();
    finishSM(pA0, pA1, alA, l_reg, pa0, pa1, pa2, pa3); SBAR();
    pv_tile<0>(o, vb0, pa0, pa1, pa2, pa3, ACT(even ? NT - 2 : NT - 1));
    if (even) { MODT(pB0, pB1, NT - 1, mwB); partialSM(pB0, pB1, m_reg, alB); __syncthreads(); RESC(alB);
        finishSM(pB0, pB1, alB, l_reg, pa0, pa1, pa2, pa3); SBAR(); pv_tile<1>(o, vb0, pa0, pa1, pa2, pa3, ACT(NT - 1)); }
    SBAR(); SEAM_K0();
    if (cur.dry) {
    } else if (cur.role == 1) {
        float* so = cur.slab + wid * 4096 + lane;
#pragma unroll
        for (int d0 = 0; d0 < 4; ++d0)
#pragma unroll
            for (int r = 0; r < 16; ++r) so[(d0 * 16 + r) * 64] = o[d0][r];
        float* sm = cur.slab + 8 * 4096 + wid * 128 + lane; sm[0] = m_reg; sm[64] = l_reg;
        asm volatile("s_waitcnt vmcnt(0)" ::: "memory");
        __syncthreads();
        if (tid == 0) { __builtin_amdgcn_fence(__ATOMIC_RELEASE, "agent"); asm volatile("s_waitcnt vmcnt(0)" ::: "memory");
                        __hip_atomic_store(cur.flag, 1u, __ATOMIC_RELAXED, __HIP_MEMORY_SCOPE_AGENT); }
    } else {
        if (cur.role == 2) {
            if (tid == 0) {
                for (int p = 0; p < cur.nother; ++p) { unsigned sp = 0u;
                    while (__hip_atomic_load(cur.flag + p * FLAG_STRIDE, __ATOMIC_RELAXED, __HIP_MEMORY_SCOPE_AGENT) == 0u) { __builtin_amdgcn_s_sleep(2); if (++sp > (1u << 22)) break; } }
                __builtin_amdgcn_fence(__ATOMIC_ACQUIRE, "agent"); asm volatile("s_waitcnt vmcnt(0)" ::: "memory");
            }
            __syncthreads();
            float* tab = (float*)(lds + LDS_MT) + wid * 96;
            const float* s0 = cur.slab; const float* s1 = cur.slab + SLAB_FLOATS; const bool two = cur.nother == 2;
            const float m0 = s0[8 * 4096 + wid * 128 + lane], l0 = s0[8 * 4096 + wid * 128 + 64 + lane];
            const float m1 = two ? s1[8 * 4096 + wid * 128 + lane] : -1e30f, l1 = two ? s1[8 * 4096 + wid * 128 + 64 + lane] : 0.f;
            const float mn = fmaxf(fmaxf(m_reg, m0), m1);
            const float fs = __builtin_amdgcn_exp2f(m_reg - mn), f0 = __builtin_amdgcn_exp2f(m0 - mn), f1 = __builtin_amdgcn_exp2f(m1 - mn);
            l_reg = l_reg * fs + l0 * f0 + l1 * f1;
            if (hi == 0) { tab[r32] = fs; tab[32 + r32] = f0; tab[64 + r32] = f1; }
            asm volatile("s_waitcnt lgkmcnt(0)" ::: "memory");
            const float* so0 = s0 + wid * 4096 + lane; const float* so1 = s1 + wid * 4096 + lane;
#pragma unroll
            for (int d0 = 0; d0 < 4; ++d0)
#pragma unroll
                for (int rb = 0; rb < 16; rb += 8) { float a0[8];
#pragma unroll
                    for (int r = 0; r < 8; ++r) a0[r] = so0[(d0 * 16 + rb + r) * 64];
#pragma unroll
                    for (int r = 0; r < 8; ++r) { const int rw = crow(rb + r, hi); o[d0][rb + r] = o[d0][rb + r] * tab[rw] + a0[r] * tab[32 + rw]; } __builtin_amdgcn_sched_barrier(0); }
            if (two) {
#pragma unroll
                for (int d0 = 0; d0 < 4; ++d0)
#pragma unroll
                    for (int rb = 0; rb < 16; rb += 8) { float a1[8];
#pragma unroll
                        for (int r = 0; r < 8; ++r) a1[r] = so1[(d0 * 16 + rb + r) * 64];
#pragma unroll
                        for (int r = 0; r < 8; ++r) { const int rw = crow(rb + r, hi); o[d0][rb + r] += a1[r] * tab[64 + rw]; } __builtin_amdgcn_sched_barrier(0); }
            }
        }
    {
        const size_t row0 = (size_t)(cur.P0 + wid * QBLK);
        const int erow = lane >> 3, ech = (lane & 7) * 8;
        if (hi == 0) li_l[r32] = l_reg; asm volatile("s_waitcnt lgkmcnt(0)" ::: "memory");
        float rli[16];
#pragma unroll
        for (int r = 0; r < 16; ++r) rli[r] = __builtin_amdgcn_rcpf(li_l[crow(r, hi)]);
        u16* stg = (u16*)(V_lds + wid * 4096);
#pragma unroll
        for (int half = 0; half < 2; ++half) {
            u32x4 gv[4];
#pragma unroll
            for (int i = 0; i < 4; ++i) gv[i] = *(const u32x4*)(cur.G + (row0 + i * 8 + erow) * PITCH + half * 64 + ech);
#pragma unroll
            for (int r = 0; r < 16; ++r) { const int orow = crow(r, hi);
#pragma unroll
                for (int dd = 0; dd < 2; ++dd) { const float v = o[2 * half + dd][r] * rli[r];
                    const float vn = __int_as_float(__builtin_amdgcn_mov_dpp(__float_as_int(v), 0xB1, 0xF, 0xF, true));
                    if ((r32 & 1) == 0) *(unsigned*)(stg + orow * 64 + dd * 32 + r32) = cvtpk(v, vn); } }
            asm volatile("s_waitcnt lgkmcnt(0)" ::: "memory");
#pragma unroll
            for (int it = 0; it < 4; ++it) { const int row = it * 8 + erow;
                const u32x4 ov = *(const u32x4*)(stg + row * 64 + ech); const u32x4 g4 = gv[it]; int y0 = 0, y1 = 0;
#pragma unroll
                for (int e = 0; e < 4; ++e) {
                    const float g0 = __uint_as_float(g4[e] << 16), g1 = __uint_as_float(g4[e] & 0xffff0000u);
                    const float s0 = g0 * __builtin_amdgcn_rcpf(1.f + __builtin_amdgcn_exp2f(-1.4426950408889634f * g0)) * Y8_SCALE;
                    const float s1 = g1 * __builtin_amdgcn_rcpf(1.f + __builtin_amdgcn_exp2f(-1.4426950408889634f * g1)) * Y8_SCALE;
                    const float a = __uint_as_float(ov[e] << 16) * s0, b = __uint_as_float(ov[e] & 0xffff0000u) * s1;
                    if (e == 0) y0 = __builtin_amdgcn_cvt_pk_fp8_f32(a, b, y0, false); else if (e == 1) y0 = __builtin_amdgcn_cvt_pk_fp8_f32(a, b, y0, true);
                    else if (e == 2) y1 = __builtin_amdgcn_cvt_pk_fp8_f32(a, b, y1, false); else y1 = __builtin_amdgcn_cvt_pk_fp8_f32(a, b, y1, true); }
                *(u32x2*)(cur.Y + (row0 + row) * YPITCH + half * 64 + ech) = (u32x2){(unsigned)y0, (unsigned)y1}; }
            asm volatile("s_waitcnt lgkmcnt(0)" ::: "memory");
        }
    }
    }
    __syncthreads();
#undef RESC
#undef KBASE
#undef ACT
#undef MLOAD
#undef MODT
#undef SEAM_K0
#undef HALF_STEP
}
#undef ROW
#undef VMW
#undef VMWN
#undef SLOAD_H
#undef SWRITE_HK
#undef SWRITE_HV
#undef SWRITE_H
#undef SBAR
#undef KSWZ
}
#ifndef REP_PHASE
#define REP_PHASE -1
#endif
namespace idx {
typedef unsigned short u16;
typedef short bf16x8 __attribute__((ext_vector_type(8)));
typedef float f32x16 __attribute__((ext_vector_type(16)));
typedef float f32x4 __attribute__((ext_vector_type(4)));
typedef unsigned u32x4 __attribute__((ext_vector_type(4)));
#define IDX_LAS __attribute__((address_space(3)))
constexpr int SEQ = 4096, PITCH = 1024, TOPK = 256;
constexpr int HW_WORDS = 16 * 260;
constexpr int LDS_S = 0, LDS_BYTES = 8 * HW_WORDS * 4;
constexpr float IDX_SCALE = 0.03125f;
__device__ __forceinline__ float bf2f(unsigned h) { return __uint_as_float(h << 16); }

__device__ __forceinline__ void unit(IDX_LAS unsigned char* lds, const u16* QI, const u16* KW, unsigned long long* Mb, int b, int t0, int wave_) {
    int tid_; asm volatile("v_mbcnt_lo_u32_b32 %0, -1, 0\n\tv_mbcnt_hi_u32_b32 %0, -1, %0\n\tv_lshl_add_u32 %0, %1, 6, %0" : "=&v"(tid_) : "s"(wave_)); const int tid = tid_, wid = __builtin_amdgcn_readfirstlane(tid >> 6), lane = tid & 63, c32 = lane & 31, hi = lane >> 5;
    const int c = t0 >> 6, N = 64 * (c + 1), nt32 = N >> 5, nt = c + 1;
    const size_t rb = (size_t)b * SEQ;
    IDX_LAS float* S = (IDX_LAS float*)(lds + LDS_S);
    bf16x8 af[4][4]; float wv[4][16];
#pragma unroll
    for (int j = 0; j < 4; ++j) {
        const int query = 2 * j + ((c32 >> 2) & 1), head = (c32 & 3) + 4 * (c32 >> 3);
        const u16* qp = QI + (rb + t0 + query) * PITCH + head * 64 + hi * 8;
#pragma unroll
        for (int ks = 0; ks < 4; ++ks) af[j][ks] = *(const bf16x8*)(qp + ks * 16);
        const u16* wp = KW + (rb + t0 + 2 * j + hi) * PITCH + 64;
        const u32x4 w0 = *(const u32x4*)wp, w1 = *(const u32x4*)(wp + 8);
#pragma unroll
        for (int e = 0; e < 4; ++e) { wv[j][2 * e] = bf2f(w0[e] & 0xffffu) * IDX_SCALE; wv[j][2 * e + 1] = __uint_as_float(w0[e] & 0xffff0000u) * IDX_SCALE;
                                      wv[j][8 + 2 * e] = bf2f(w1[e] & 0xffffu) * IDX_SCALE; wv[j][8 + 2 * e + 1] = __uint_as_float(w1[e] & 0xffff0000u) * IDX_SCALE; }
    }
    const u16* kbase = KW + (rb + c32) * PITCH + hi * 8;
    bf16x8 bn[4];
    if (wid < nt32) {
#pragma unroll
        for (int ks = 0; ks < 4; ++ks) bn[ks] = *(const bf16x8*)(kbase + (size_t)(wid * 32) * PITCH + ks * 16);
    }
    for (int kt = wid; kt < nt32; kt += 8) {
        bf16x8 bc[4];
#pragma unroll
        for (int ks = 0; ks < 4; ++ks) bc[ks] = bn[ks];
        if (kt + 8 < nt32) {
#pragma unroll
            for (int ks = 0; ks < 4; ++ks) bn[ks] = *(const bf16x8*)(kbase + (size_t)((kt + 8) * 32) * PITCH + ks * 16);
        }
#pragma unroll
        for (int j = 0; j < 4; ++j) {
            f32x16 acc = {};
#pragma unroll
            for (int ks = 0; ks < 4; ++ks) acc = __builtin_amdgcn_mfma_f32_32x32x16_bf16(af[j][ks], bc[ks], acc, 0, 0, 0);
            float s = 0.f;
#pragma unroll
            for (int r = 0; r < 16; ++r) s = fmaf(wv[j][r], fmaxf(acc[r], 0.f), s);
            S[(2 * j + hi) * SEQ + kt * 32 + c32] = s;
        }
    }
    __syncthreads();
    {
        const IDX_LAS float* row = S + wid * SEQ;
        unsigned key[64];
#pragma unroll
        for (int g = 0; g < 8; ++g) {
            if (g * 8 < nt) {
#pragma unroll
                for (int e = 0; e < 8; ++e) { const int i = g * 8 + e; const unsigned u = __float_as_uint(row[i * 64 + lane]);
                    const unsigned k = u ^ ((unsigned)((int)u >> 31) | 0x80000000u); key[i] = (i < nt) ? k : 0u; }
            } else {
#pragma unroll
                for (int e = 0; e < 8; ++e) key[g * 8 + e] = 0u;
            }
        }
        __syncthreads();
        IDX_LAS unsigned* hw = (IDX_LAS unsigned*)lds + wid * HW_WORDS;
        const unsigned dummy = 4096u + (unsigned)lane;
        const unsigned rot = (unsigned)lane * 4u;
#define IDX_CLEAR() do { _Pragma("unroll") for (int j = 0; j < 16; ++j) *(IDX_LAS u32x4*)(hw + j * 256 + lane * 4) = (u32x4){0u, 0u, 0u, 0u}; hw[4096 + lane] = 0u; } while (0)
#define IDX_SCAN(BIN, ABOVE, CNT) do { \
            asm volatile("s_waitcnt lgkmcnt(0)" ::: "memory"); \
            unsigned tot_ = 0u; \
            _Pragma("unroll") for (int j = 0; j < 16; ++j) { const u32x4 v_ = *(IDX_LAS u32x4*)(hw + lane * 64 + ((rot + 4u * j) & 63u)); tot_ += (v_[0] + v_[1]) + (v_[2] + v_[3]); } \
            unsigned v1_ = tot_; \
            _Pragma("unroll") for (int o = 1; o < 64; o <<= 1) { const unsigned t_ = __shfl_down(v1_, o); if (lane + o < 64) v1_ += t_; } \
            const unsigned ab1_ = v1_ - tot_; \
            const unsigned long long f1_ = __ballot(ab1_ < (unsigned)kk && (unsigned)kk <= ab1_ + tot_); \
            const int L_ = (int)__builtin_ctzll(f1_); \
            const unsigned aL_ = (unsigned)__shfl((int)ab1_, L_); \
            const unsigned c_ = hw[L_ * 64 + lane]; \
            unsigned v2_ = c_; \
            _Pragma("unroll") for (int o = 1; o < 64; o <<= 1) { const unsigned t_ = __shfl_down(v2_, o); if (lane + o < 64) v2_ += t_; } \
            const unsigned ab2_ = v2_ - c_ + aL_; \
            const unsigned long long f2_ = __ballot(ab2_ < (unsigned)kk && (unsigned)kk <= ab2_ + c_); \
            const int l2_ = (int)__builtin_ctzll(f2_); \
            BIN = (unsigned)(L_ * 64 + l2_); ABOVE = (unsigned)__shfl((int)ab2_, l2_); CNT = (unsigned)__shfl((int)c_, l2_); } while (0)
        int kk = TOPK; unsigned lo, bin, above, ties;
        IDX_CLEAR();
#pragma unroll
        for (int g = 0; g < 8; ++g) if (g * 8 < nt) {
#pragma unroll
            for (int e = 0; e < 8; ++e) __hip_atomic_fetch_add(hw + (key[g * 8 + e] >> 20), 1u, __ATOMIC_RELAXED, __HIP_MEMORY_SCOPE_WORKGROUP);
        }
        IDX_SCAN(bin, above, ties); lo = bin << 20; kk -= (int)above;
        if (ties != (unsigned)kk) {
            IDX_CLEAR();
#pragma unroll
            for (int g = 0; g < 8; ++g) if (g * 8 < nt) {
#pragma unroll
                for (int e = 0; e < 8; ++e) { unsigned t = (key[g * 8 + e] - lo) >> 8; t = t < dummy ? t : dummy;
                    __hip_atomic_fetch_add(hw + t, 1u, __ATOMIC_RELAXED, __HIP_MEMORY_SCOPE_WORKGROUP); }
            }
            IDX_SCAN(bin, above, ties); lo += bin << 8; kk -= (int)above;
            if (ties != (unsigned)kk) {
                IDX_CLEAR();
#pragma unroll
                for (int g = 0; g < 8; ++g) if (g * 8 < nt) {
#pragma unroll
                    for (int e = 0; e < 8; ++e) { unsigned t = key[g * 8 + e] - lo; t = t < 256u ? t : dummy;
                        __hip_atomic_fetch_add(hw + t, 1u, __ATOMIC_RELAXED, __HIP_MEMORY_SCOPE_WORKGROUP); }
                }
                IDX_SCAN(bin, above, ties); lo += bin; kk -= (int)above;
            }
        }
#undef IDX_CLEAR
#undef IDX_SCAN
        const unsigned thr = lo; const unsigned need = (unsigned)kk;
        const int ntw = 4 * (c >> 2) + 4;
        unsigned mlo = 0u, mhi = 0u;
        if (ties == need) {
#pragma unroll
            for (int g = 0; g < 8; ++g) if (g * 8 < nt) {
#pragma unroll
                for (int e = 0; e < 8; ++e) { const int i = g * 8 + e; const unsigned long long bal = __ballot(key[i] >= thr && i < nt);
                    if (lane == i) { mlo = (unsigned)bal; mhi = (unsigned)(bal >> 32); } }
            }
        } else {
            unsigned running = 0u;
#pragma unroll
            for (int i = 0; i < 64; ++i) {
                if (i < nt) { const bool eq = key[i] == thr; const unsigned long long eb = __ballot(eq);
                    const unsigned rank = running + __builtin_amdgcn_mbcnt_hi((unsigned)(eb >> 32), __builtin_amdgcn_mbcnt_lo((unsigned)eb, 0u));
                    const bool sel = (key[i] > thr) || (eq && rank < need);
                    const unsigned long long bal = __ballot(sel);
                    if (lane == i) { mlo = (unsigned)bal; mhi = (unsigned)(bal >> 32); }
                    running += (unsigned)__popcll(eb); }
            }
        }
        if (lane < ntw) Mb[(size_t)lane * SEQ + t0 + wid] = ((unsigned long long)mhi << 32) | mlo;
    }
    __syncthreads();
}
}
#define GAS __attribute__((address_space(1)))
#define LAS __attribute__((address_space(3)))
typedef unsigned short bf16;
typedef unsigned v4u __attribute__((ext_vector_type(4)));
typedef float f32x4 __attribute__((ext_vector_type(4)));
typedef short bf16x8 __attribute__((ext_vector_type(8)));
typedef GAS unsigned gu32;
typedef GAS unsigned long long gu64;
#define RLX_AGENT __ATOMIC_RELAXED, __HIP_MEMORY_SCOPE_AGENT
#define LDS_WAIT() asm volatile("s_waitcnt lgkmcnt(0)" ::: "memory")
#define VM_WAIT() asm volatile("s_waitcnt vmcnt(0)" ::: "memory")
__device__ __forceinline__ unsigned long long rt() { return __builtin_amdgcn_s_memrealtime(); }
__device__ __forceinline__ unsigned f2bf(float f) { unsigned u = __builtin_bit_cast(unsigned, f); return (u + 0x7fffu + ((u >> 16) & 1u)) >> 16; }
__device__ __forceinline__ unsigned pk2(float lo, float hi) { return f2bf(lo) | (f2bf(hi) << 16); }

#define XB_TMO      128
#define XB_XCNT(j)  (256  + 64 * (j))
#define XB_XSUB(j)  (1280 + 64 * (j))
#define XB_XGEN(j)  (2304 + 64 * (j))
#define XB_TOP      3328
#define XB_TOPGEN   3392
#define XCD_BAR_WORDS 3456
#define XB_SPIN_CAP (1u << 18)

__device__ __forceinline__ unsigned xb_ld(unsigned* p)              { return __hip_atomic_load(p, __ATOMIC_RELAXED, __HIP_MEMORY_SCOPE_AGENT); }
__device__ __forceinline__ unsigned xb_add(unsigned* p, unsigned v) { return __hip_atomic_fetch_add(p, v, __ATOMIC_RELAXED, __HIP_MEMORY_SCOPE_AGENT); }
__device__ __forceinline__ unsigned xb_xcc_id() { return (unsigned)__builtin_amdgcn_s_getreg((3 << 11) | 20) & 0xFu; }
#define XB_SPIN(cond, bar) do { unsigned _sp = 0; while (cond) { __builtin_amdgcn_s_sleep(1); \
    if ((++_sp & 255u) == 0u) { if (xb_ld(&(bar)[XB_TMO])) break; if (_sp > XB_SPIN_CAP) { atomicAdd(&(bar)[XB_TMO], 1u); break; } } } } while (0)

struct XcdBarrier {
    unsigned* bar; unsigned x;
    volatile LAS unsigned* st;
};

__device__ __forceinline__ XcdBarrier xcd_barrier_post(unsigned* bar, volatile LAS unsigned* st) {
    XcdBarrier b; b.bar = bar; b.x = xb_xcc_id(); b.st = st;
    if (threadIdx.x == 0) (void)xb_add(&bar[XB_XCNT(b.x)], 1u);
    return b;
}
__device__ __forceinline__ void xcd_barrier_complete(unsigned* bar, unsigned x, unsigned& nloc, unsigned& nx) {
    const unsigned G = gridDim.x * gridDim.y * gridDim.z;
    unsigned sum, cnt, mine, sp = 0u;
    for (;;) {
        sum = 0u; cnt = 0u; mine = 0u;
#pragma unroll
        for (unsigned j = 0; j < 16; ++j) { const unsigned c = xb_ld(&bar[XB_XCNT(j)]); sum += c; cnt += (c > 0u) ? 1u : 0u; mine = (j == x) ? c : mine; }
        if (sum == G) break;
        __builtin_amdgcn_s_sleep(1);
        if ((++sp & 255u) == 0u) { if (xb_ld(&bar[XB_TMO])) break; if (sp > XB_SPIN_CAP) { atomicAdd(&bar[XB_TMO], 1u); break; } }
    }
    nloc = mine > 0u ? mine : 1u; nx = cnt > 0u ? cnt : 1u;
}

__device__ __forceinline__ void xcd_barrier(const XcdBarrier& b) {
    asm volatile("s_waitcnt vmcnt(0)" ::: "memory");
    __syncthreads();
    if (threadIdx.x == 0) {
        unsigned* bar = b.bar;
        __builtin_amdgcn_s_waitcnt(0);
        unsigned nloc = b.st[0], nx = b.st[1];
        if (nloc == 0u) { xcd_barrier_complete(bar, b.x, nloc, nx); b.st[0] = nloc; b.st[1] = nx; }
        const unsigned old = xb_add(&bar[XB_XSUB(b.x)], 1u);
        const unsigned gen = old / nloc;
        if (old + 1u == (gen + 1u) * nloc) {
            __builtin_amdgcn_fence(__ATOMIC_RELEASE, "agent");
            asm volatile("s_waitcnt vmcnt(0)" ::: "memory");
            const unsigned og = xb_add(&bar[XB_TOP], 1u);
            const unsigned tg = og / nx;
            if (og + 1u == (tg + 1u) * nx) xb_add(&bar[XB_TOPGEN], 1u);
            else XB_SPIN(xb_ld(&bar[XB_TOPGEN]) == tg, bar);
            __builtin_amdgcn_fence(__ATOMIC_ACQUIRE, "agent");
            xb_add(&bar[XB_XGEN(b.x)], 1u);
            asm volatile("s_waitcnt vmcnt(0)" ::: "memory");
        } else {
            XB_SPIN(xb_ld(&bar[XB_XGEN(b.x)]) == gen, bar);
            __builtin_amdgcn_fence(__ATOMIC_ACQUIRE, "agent");
            asm volatile("s_waitcnt vmcnt(0)" ::: "memory");
        }
    }
    __syncthreads();
}

constexpr int NWAVES = 8;
constexpr int BATCH = 2, T = 4096, DM = 2048, M = BATCH * T;
constexpr int D_IN = 9296, N8 = 8192, NB = D_IN - N8, NB_PAD = 1280;
constexpr float W8_SCALE = 64.f;
constexpr int NTENS = 10, TP = 1024;
constexpr float EPS = 1e-6f;
constexpr float LOG2E = 1.4426950408889634f;
constexpr float C2 = 0.08838834764831845f * 1.4426950408889634f;
constexpr int MAX_REL = 128, NREL = 2 * MAX_REL + 1;

constexpr size_t MiB = 1u << 20;
constexpr size_t WS_CTL = 0, CTL_ZERO_BYTES = 1 * MiB;
constexpr size_t WS_W8 = 1 * MiB;
constexpr size_t WS_WB = 17 * MiB;
constexpr size_t WS_XN8 = 22 * MiB;
constexpr size_t WS_WOUT = 38 * MiB;
constexpr size_t WS_XN = 46 * MiB;
constexpr size_t WS_PROJ = 78 * MiB;
constexpr size_t WS_MASK = 238 * MiB;
constexpr size_t WS_PART = 242 * MiB;
constexpr size_t WS_END = 243 * MiB;
constexpr int CW_BAR = 4096;
constexpr int CW_FLAG = 16384;
constexpr size_t WS_SLAB = WS_W8;
static_assert(256 * (size_t)att::SLAB_FLOATS * 4 <= 37 * MiB && (CW_FLAG + 256 * 64) * 4 <= (int)CTL_ZERO_BYTES, "slabs / flags");

constexpr int RING_OFF = 0, RING_BYTES = 139264;
constexpr int LDSCTL_OFF = RING_BYTES, MISC_OFF = LDSCTL_OFF + 320;
constexpr int LDS_BYTES = 147456;
static_assert(MISC_OFF + 128 <= LDS_BYTES && idx::LDS_BYTES <= RING_BYTES && att::LDS_BYTES <= RING_BYTES && pg8::STAGE_BYTES <= RING_BYTES, "LDS map");

__device__ __forceinline__ int lane_id_asm() { int l; asm volatile("v_mbcnt_lo_u32_b32 %0, -1, 0\n\tv_mbcnt_hi_u32_b32 %0, -1, %0" : "=&v"(l)); return l; }
struct Frame {
    LAS unsigned char* lds;
    volatile LAS unsigned* MISC;
    gu32* ctl;
    int tid, lane, wave;
    int vcu, G;
};

__device__ __forceinline__ float wave_sum(float v) {
#pragma unroll
    for (int o = 1; o < 64; o <<= 1) v += __shfl_xor(v, o);
    return v;
}
template <bool FP8OUT>
__device__ __forceinline__ void p0_transpose_item(const float* W, int K, int ldw, int n_base, int n_lim, int NP, void* WTv, float scale, LAS float* scr, int item, int lane) {
    const int nblk = NP / 64, kb = item / nblk, nb = item % nblk, k0 = 64 * kb, n0 = 64 * nb;
    const int l16 = lane & 15, kr = lane >> 4;
    const bool inb = (n_base + n0 + 4 * l16) < n_lim;
    f32x4 v[16];
#pragma unroll
    for (int i = 0; i < 16; ++i) v[i] = inb ? *(const GAS f32x4*)(W + (size_t)(k0 + 4 * i + kr) * ldw + n_base + n0 + 4 * l16) : (f32x4){0.f, 0.f, 0.f, 0.f};
#pragma unroll
    for (int i = 0; i < 16; ++i) { LAS float* d = scr + (4 * l16) * 65 + 4 * i + kr; d[0] = v[i].x * scale; d[65] = v[i].y * scale; d[130] = v[i].z * scale; d[195] = v[i].w * scale; }
    LDS_WAIT(); asm volatile("" ::: "memory");
    const int c = lane & 7;
#pragma unroll
    for (int j = 0; j < 8; ++j) { const int n = (lane >> 3) + 8 * j; const LAS float* s = scr + n * 65 + 8 * c;
        if constexpr (FP8OUT) {
            int lo = __builtin_amdgcn_cvt_pk_fp8_f32(s[0], s[1], 0, false); lo = __builtin_amdgcn_cvt_pk_fp8_f32(s[2], s[3], lo, true);
            int hi = __builtin_amdgcn_cvt_pk_fp8_f32(s[4], s[5], 0, false); hi = __builtin_amdgcn_cvt_pk_fp8_f32(s[6], s[7], hi, true);
            *(GAS unsigned long long*)((unsigned char*)WTv + (size_t)(n0 + n) * K + k0 + 8 * c) = ((unsigned long long)(unsigned)hi << 32) | (unsigned)lo;
        } else {
            v4u o; o.x = pk2(s[0], s[1]); o.y = pk2(s[2], s[3]); o.z = pk2(s[4], s[5]); o.w = pk2(s[6], s[7]);
            *(GAS v4u*)((bf16*)WTv + (size_t)(n0 + n) * K + k0 + 8 * c) = o; } }
    LDS_WAIT(); asm volatile("" ::: "memory");
}
__device__ __forceinline__ void rms_row_to_bf16(int lane, const float* xrow, const float* gain, bf16* orow, unsigned char* orow8) {
    const GAS f32x4* xr = (const GAS f32x4*)xrow + lane; const GAS f32x4* gr = (const GAS f32x4*)gain + lane;
    f32x4 v[8]; float s = 0.f;
#pragma unroll
    for (int j = 0; j < 8; ++j) { v[j] = xr[64 * j]; s += (v[j].x * v[j].x + v[j].y * v[j].y) + (v[j].z * v[j].z + v[j].w * v[j].w); }
    const float rstd = 1.f / sqrtf(wave_sum(s) * (1.f / DM) + EPS);
    GAS unsigned long long* o8 = (GAS unsigned long long*)orow + lane; GAS unsigned* o4 = (GAS unsigned*)orow8 + lane;
#pragma unroll
    for (int j = 0; j < 8; ++j) { const f32x4 g = gr[64 * j]; const float a = v[j].x * rstd * g.x, b = v[j].y * rstd * g.y, c = v[j].z * rstd * g.z, d = v[j].w * rstd * g.w;
        o8[64 * j] = (unsigned long long)pk2(a, b) | ((unsigned long long)pk2(c, d) << 32);
        int q = __builtin_amdgcn_cvt_pk_fp8_f32(a, b, 0, false); q = __builtin_amdgcn_cvt_pk_fp8_f32(c, d, q, true); o4[64 * j] = (unsigned)q; }
}


#ifdef DBG_CHECK
__device__ __forceinline__ float dbg_row(int mode, int lane, const bf16* Q, const bf16* K, const bf16* V, const bf16* G, const bf16* Yrow, const unsigned long long* Mb,
                                         const float* rel_bias_h, float nslope, int t) {
    const unsigned qw = *(const unsigned*)(Q + (size_t)t * 1024 + 2 * lane);
    const float q0 = __uint_as_float(qw << 16), q1 = __uint_as_float(qw & 0xffff0000u);
    const int c = t >> 6; const int s_lo = (mode == 0) ? ((c - 8) > 0 ? (c - 8) * 64 : 0) : 0, s_hi = (c + 1) * 64;
    float m = -1e30f, l = 0.f, o0 = 0.f, o1 = 0.f;
    for (int s = s_lo; s < s_hi; ++s) {
        if (mode == 1) { const unsigned long long w = Mb[(size_t)(s >> 6) * T + t]; if (!((w >> (s & 63)) & 1ull)) continue; }
        const unsigned kw = *(const unsigned*)(K + (size_t)s * 1024 + 2 * lane);
        float part = q0 * __uint_as_float(kw << 16) + q1 * __uint_as_float(kw & 0xffff0000u);
        float sc = wave_sum(part);
        if (mode == 0) { int r = t - s; r = r < -128 ? -128 : (r > 128 ? 128 : r); sc += rel_bias_h[r + 128] * LOG2E; }
        else { int d = t - s; d = d < 0 ? -d : d; sc += nslope * (float)d; }
        const float mn = fmaxf(m, sc), a = __builtin_amdgcn_exp2f(m - mn), p = __builtin_amdgcn_exp2f(sc - mn);
        const unsigned vw = *(const unsigned*)(V + (size_t)s * 1024 + 2 * lane);
        l = l * a + p; o0 = o0 * a + p * __uint_as_float(vw << 16); o1 = o1 * a + p * __uint_as_float(vw & 0xffff0000u); m = mn;
    }
    const unsigned gw = *(const unsigned*)(G + (size_t)t * 1024 + 2 * lane);
    const float g0 = __uint_as_float(gw << 16), g1 = __uint_as_float(gw & 0xffff0000u);
    const float y0 = o0 / l * (g0 / (1.f + expf(-g0))), y1 = o1 / l * (g1 / (1.f + expf(-g1)));
    const unsigned yw = *(const unsigned*)(Yrow + 2 * lane);
    float d = fmaxf(fabsf(y0 - __uint_as_float(yw << 16)), fabsf(y1 - __uint_as_float(yw & 0xffff0000u)));
#pragma unroll
    for (int o = 1; o < 64; o <<= 1) d = fmaxf(d, __shfl_xor(d, o));
    return d;
}
#endif

#ifndef REP_PHASE
#define REP_PHASE -1
#endif
#ifndef DRY_MODE
#define DRY_MODE 0
#endif
struct Args { const float* x; const float* norm_gain; const float* w_in; const float* rel_bias; const float* w_out; const float* final_gain; float* out; unsigned char* ws; };
__global__ void __launch_bounds__(NWAVES * 64, 2) skel_fwd(Args args) {
    extern __shared__ __attribute__((aligned(16))) unsigned char lds[];
    Frame F;
    F.lds = (LAS unsigned char*)lds;
    F.MISC = (volatile LAS unsigned*)(F.lds + MISC_OFF);
    F.wave = __builtin_amdgcn_readfirstlane((int)threadIdx.x >> 6); F.lane = lane_id_asm(); F.tid = F.wave * 64 + F.lane;
    F.G = gridDim.x; { const int bx = blockIdx.x; F.vcu = (F.G % 8 == 0) ? (bx % 8) * (F.G / 8) + bx / 8 : bx; }
    unsigned char* ws = args.ws;
    F.ctl = (gu32*)(ws + WS_CTL);
    unsigned char* W8 = ws + WS_W8; bf16* WB = (bf16*)(ws + WS_WB); unsigned char* XN8 = ws + WS_XN8; unsigned char* Wout8 = ws + WS_WOUT; bf16* XN = (bf16*)(ws + WS_XN); unsigned char* Y = (unsigned char*)XN;
    bf16* PROJ = (bf16*)(ws + WS_PROJ); unsigned long long* MASK = (unsigned long long*)(ws + WS_MASK); float* PART = (float*)(ws + WS_PART);
    for (int u = F.tid; u < (LDS_BYTES - LDSCTL_OFF) / 4; u += NWAVES * 64) ((LAS unsigned*)(F.lds + LDSCTL_OFF))[u] = 0u;
    __syncthreads();
    XcdBarrier bar = xcd_barrier_post((unsigned*)(F.ctl + CW_BAR), F.MISC + 8);
    const int gw = F.vcu * NWAVES + F.wave, NGW = F.G * NWAVES;
#ifdef DBG_TS
#ifndef DBG_TS_OFF
#define DBG_TS_OFF 0ull
#endif
    int nts_ = 0;
#define STAMP() do { if (F.wave == 0 && lane_id_asm() == 0) ((volatile LAS unsigned long long*)(F.lds + LDSCTL_OFF))[nts_] = rt(); ++nts_; } while (0)
#else
#define STAMP() do {} while (0)
#endif
    STAMP();

    for (int rep_ = 0; rep_ < (REP_PHASE == 0 ? 2 : 1); ++rep_) {
    {
        LAS float* scr = (LAS float*)(F.lds + RING_OFF + F.wave * 16640);
        constexpr int I_8 = (DM / 64) * (N8 / 64), I_B = (DM / 64) * (NB_PAD / 64), I_OUT = (DM / 64) * (DM / 64);
        for (int it = gw; it < I_8 + I_B + I_OUT; it += NGW) {
            if (it < I_8) p0_transpose_item<true>(args.w_in, DM, D_IN, 0, N8, N8, W8, W8_SCALE, scr, it, F.lane);
            else if (it < I_8 + I_B) p0_transpose_item<false>(args.w_in, DM, D_IN, N8, D_IN, NB_PAD, WB, 1.f, scr, it - I_8, F.lane);
            else p0_transpose_item<true>(args.w_out, DM, DM, 0, DM, DM, Wout8, W8_SCALE, scr, it - I_8 - I_B, F.lane);
        }
        for (int m = gw; m < M; m += NGW) rms_row_to_bf16(F.lane, args.x + (size_t)m * DM, args.norm_gain, XN + (size_t)m * DM, XN8 + (size_t)m * DM);
        for (int e = blockIdx.x * (NWAVES * 64) + F.tid; e < BATCH * 4 * 256; e += F.G * NWAVES * 64) {
            const int b = e / 1024, jt = (e >> 8) & 3, t = e & 255;
            MASK[((size_t)b * 64 + jt) * T + t] = (jt <= (t >> 6)) ? ~0ull : 0ull;
        }
    }
    xcd_barrier(bar); STAMP();
    }

    for (int rep_ = 0; rep_ < (REP_PHASE == 1 ? 2 : 1); ++rep_) {
    {
        {
            pg8::Gemm g{XN, WB, M, NB_PAD, DM}; pg8::StaticOrder S; S.init(M, NB_PAD, F.G, (int)blockIdx.x);
            pg8::EpiSplit E{PROJ, TP, TP, (size_t)M * TP, C2, 1.f, N8};
            pg8::gemm_phase<pg8::EpiSplit, pg8::StaticOrder, true, true, false>(F.lds + RING_OFF, g, S, E, F.wave);
        }
        {
            pg8::Gemm g{(const pg8::bf16_t*)XN8, (const pg8::bf16_t*)W8, M, N8, DM / 2}; pg8::StaticOrder S; S.init(M, N8, F.G, (int)blockIdx.x);
            pg8::EpiSplit E{PROJ, TP, TP, (size_t)M * TP, C2, 1.f / W8_SCALE, 0};
            pg8::gemm_phase<pg8::EpiSplit, pg8::StaticOrder, true, true, true>(F.lds + RING_OFF, g, S, E, F.wave);
        }
    }
    xcd_barrier(bar); STAMP();
    }

    for (int rep_ = 0; rep_ < (REP_PHASE == 2 ? 2 : 1); ++rep_) {
    {
        const size_t TS = (size_t)M * TP;
        for (int ra_ = 0; ra_ < (REP_PHASE == 20 ? 2 : 1); ++ra_)
        for (int a = F.vcu; a < 256; a += F.G) {
            const int bh = a >> 4, qb = a & 15, b = bh >> 3, h = bh & 7;
            float* bt = (float*)((char*)lds + RING_OFF + att::LDS_BT);
            for (int i = F.tid; i < NREL; i += NWAVES * 64) bt[i] = args.rel_bias[h * NREL + i] * LOG2E;
            const size_t ro = (size_t)b * T * TP + (size_t)h * 128;
            att::BlockRef cur{PROJ + 0 * TS + ro, PROJ + 1 * TS + ro, PROJ + 2 * TS + ro, PROJ + 3 * TS + ro, Y + (size_t)b * T * DM + h * 128, nullptr, qb * 256, 0.f,
                              (4 * qb - 8) > 0 ? (4 * qb - 8) : 0, 4 * qb + 4, 0, nullptr, nullptr, 0, 0};
            att::Seam S;
            att::NextRef nx{cur.Q, cur.K, cur.V, cur.P0, cur.ja};
            att::attn_prime<0>(cur, (char*)lds + RING_OFF, S, F.wave);
            att::attn_block<0>(cur, nx, (char*)lds + RING_OFF, S, F.wave);
        }
        __syncthreads();
        for (int ri_ = 0; ri_ < (REP_PHASE == 21 ? 2 : 1); ++ri_)
        for (int cu = (int)blockIdx.x; cu < 256; cu += F.G)
            for (int rnd = 0; rnd < 4; ++rnd) {
                const int u = (rnd & 1) ? (rnd * 256 + 255 - cu) : (rnd * 256 + cu);
                if (u >= 960) continue;
                const int c = 63 - (u >> 4), b = (u >> 3) & 1, t0 = c * 64 + (u & 7) * 8;
                idx::unit(F.lds + RING_OFF, PROJ + 8 * TS, PROJ + 9 * TS, MASK + (size_t)b * 64 * T, b, t0, F.wave);
            }
    }
    xcd_barrier(bar); STAMP();
    }

    for (int rep_ = 0; rep_ < (REP_PHASE == 3 ? 2 : 1); ++rep_) {
    {
        const size_t TS = (size_t)M * TP;
        for (int a = F.vcu; a < 256; a += F.G) {
            const int bh = a >> 4, k = a & 15, b = bh >> 3, h = bh & 7, lo = 34 * k, hi = lo + 34;
            const size_t ro = (size_t)b * T * TP + (size_t)h * 128;
            const float slope = __builtin_amdgcn_exp2f(-(float)(h + 1));
            float* slabs = (float*)(ws + WS_SLAB); unsigned* flags = (unsigned*)(F.ctl + CW_FLAG);
#define PIECE_OF(qb_) ({ const int Ls_ = 544 - 2 * ((qb_) + 1) * ((qb_) + 2), Le_ = Ls_ + 4 * ((qb_) + 1); const int a_ = lo > Ls_ ? lo : Ls_, e_ = hi < Le_ ? hi : Le_; (a_ >= e_) ? -1 : ((a_ - Ls_) | ((e_ - Ls_) << 8)); })
#define MAKE_REF(R, qb_) do { const int pc_ = PIECE_OF(qb_); const int ta_ = pc_ & 255, tb_ = pc_ >> 8, nt_ = 4 * ((qb_) + 1); \
                R.Q = PROJ + 4 * TS + ro; R.K = PROJ + 5 * TS + ro; R.V = PROJ + 6 * TS + ro; R.G = PROJ + 7 * TS + ro; R.Y = Y + (size_t)b * T * DM + 1024 + h * 128; R.M = MASK + (size_t)b * 64 * T; \
                R.P0 = (qb_) * 256; R.nslope = -slope * LOG2E; R.ja = ta_; R.jb = tb_; R.role = (ta_ == 0 && tb_ == nt_) ? 0 : (ta_ == 0 ? 2 : 1); \
                R.slab = slabs + (size_t)(R.role == 2 ? a + 1 : a) * att::SLAB_FLOATS; R.flag = flags + (R.role == 2 ? a + 1 : a) * att::FLAG_STRIDE; R.nother = (nt_ - tb_) > 34 ? 2 : 1; R.dry = (rep_ == 1) ? DRY_MODE : 0; } while (0)
            int qb = 15; while (PIECE_OF(qb) < 0) --qb;
            att::BlockRef cur; MAKE_REF(cur, qb);
            att::Seam S;
            att::attn_prime<1>(cur, (char*)lds + RING_OFF, S, F.wave);
            for (;;) {
                const int qn = qb - 1; const int pn = (qn >= 0) ? PIECE_OF(qn >= 0 ? qn : 0) : -1; const bool more = pn >= 0;
                att::NextRef nx{cur.Q, cur.K, cur.V, more ? qn * 256 : cur.P0, more ? (pn & 255) : cur.ja};
                att::attn_block<1>(cur, nx, (char*)lds + RING_OFF, S, F.wave);
                if (!more) break;
                qb = qn; MAKE_REF(cur, qb);
            }
#undef PIECE_OF
#undef MAKE_REF
        }
    }
    xcd_barrier(bar); STAMP();
    }

    for (int rep_ = 0; rep_ < (REP_PHASE == 4 ? 2 : 1); ++rep_) {
    {
        pg8::Gemm g{(const pg8::bf16_t*)Y, (const pg8::bf16_t*)Wout8, M, DM, DM / 2}; pg8::StaticOrder S; S.init(M, DM, F.G, (int)blockIdx.x);
        pg8::EpiResid E{args.x, args.out, PART, DM, 1.f / (W8_SCALE * att::Y8_SCALE)};
        pg8::gemm_phase<pg8::EpiResid, pg8::StaticOrder, true, true, true>(F.lds + RING_OFF, g, S, E, F.wave);
    }
    xcd_barrier(bar); STAMP();
    }

    F.lane = lane_id_asm();
    for (int m = F.vcu * NWAVES + F.wave; m < M; m += NGW) {
        float s = (F.lane < 32) ? PART[(size_t)m * 32 + F.lane] : 0.f;
        s = wave_sum(s);
        const float rstd = 1.f / sqrtf(s * (1.f / DM) + EPS);
        GAS f32x4* xr = (GAS f32x4*)(args.out + (size_t)m * DM) + F.lane; const GAS f32x4* gr = (const GAS f32x4*)args.final_gain + F.lane;
#pragma unroll
        for (int j = 0; j < 8; ++j) { const f32x4 v = xr[64 * j], g = gr[64 * j]; xr[64 * j] = (f32x4){v.x * rstd * g.x, v.y * rstd * g.y, v.z * rstd * g.z, v.w * rstd * g.w}; }
    }

#ifdef DBG_TS
    xcd_barrier(bar); STAMP();
    if (blockIdx.x == 0 && F.wave == 0 && lane_id_asm() == 0) { volatile LAS unsigned long long* ts_ = (volatile LAS unsigned long long*)(F.lds + LDSCTL_OFF); args.out[0] += 1000.f * (float)((ts_[DBG_TS] - ts_[DBG_TS - 1] + DBG_TS_OFF) / 1000ull); }
#endif
#ifdef DBG_CHECK
    xcd_barrier(bar);
    {
        const size_t TS = (size_t)M * TP;
#if DBG_WHAT == 0
        for (int it = gw; it < M * 16; it += NGW) {
            const int m_ = it >> 4, mode = (it >> 3) & 1, h = it & 7, b = m_ / T, t = m_ % T;
            if (mode != DBG_CHECK) continue;
            const size_t ro = (size_t)b * T * TP + (size_t)h * 128; const int tb = mode * 4;
            const float slope = __builtin_amdgcn_exp2f(-(float)(h + 1));
            const float d = dbg_row(mode, F.lane, PROJ + (tb + 0) * TS + ro, PROJ + (tb + 1) * TS + ro, PROJ + (tb + 2) * TS + ro, PROJ + (tb + 3) * TS + ro,
                                    Y + (size_t)m_ * DM + mode * 1024 + h * 128, MASK + (size_t)b * 64 * T, args.rel_bias + h * NREL, -slope * LOG2E, t);
            if (F.lane == 0) atomicMax((unsigned*)(F.ctl + 8), __float_as_uint(d));
        }
#elif DBG_WHAT == 6
        for (int it = gw; it < 32 * 37 * 64; it += NGW) {
            const int tile = it >> 6, k = it & 63, pm = tile / 37, pn = tile % 37;
            const unsigned hsh = (unsigned)it * 2654435761u; const int m_ = pm * 256 + (hsh >> 8) % 256, n_ = pn * 256 + (hsh >> 20) % 256;
            if (n_ >= D_IN) continue;
            const float* xr = args.x + (size_t)m_ * DM; float ss = 0.f;
            for (int j = 0; j < 32; ++j) { const float v = xr[F.lane + 64 * j]; ss += v * v; }
            const float rstd = 1.f / sqrtf(wave_sum(ss) * (1.f / DM) + EPS); float acc = 0.f;
            for (int j = 0; j < 32; ++j) { const int kk = F.lane + 64 * j; const float hv = __uint_as_float(f2bf(xr[kk] * rstd * args.norm_gain[kk]) << 16);
                acc += hv * __uint_as_float(f2bf(args.w_in[(size_t)kk * D_IN + n_]) << 16); }
            acc = wave_sum(acc);
            const int tt = n_ >> 10; if (tt == 0 || tt == 4) acc *= C2;
            const float got = __uint_as_float((unsigned)PROJ[(size_t)tt * TS + (size_t)m_ * TP + (n_ & 1023)] << 16);
            const float d = fabsf(got - acc) / (fabsf(acc) * 0.01f + 0.02f);
            if (F.lane == 0) atomicMax((unsigned*)(F.ctl + 8), __float_as_uint(d));
        }
#elif DBG_WHAT == 7
        for (int m_ = F.vcu; m_ < M; m_ += 64 * F.G / 64 * 1) { if ((m_ % 61) != 0) continue;
            float z[4]; float ssq = 0.f;
            for (int q = 0; q < 4; ++q) { const int n_ = F.wave * 256 + q * 64 + F.lane; float acc = 0.f;
                for (int kk = 0; kk < DM; ++kk) acc += __uint_as_float((unsigned)Y[(size_t)m_ * DM + kk] << 16) * __uint_as_float(f2bf(args.w_out[(size_t)kk * DM + n_]) << 16);
                z[q] = args.x[(size_t)m_ * DM + n_] + acc; ssq += z[q] * z[q]; }
            ssq = wave_sum(ssq);
            LAS float* red = (LAS float*)(F.lds + RING_OFF);
            __syncthreads(); if (F.lane == 0) red[F.wave] = ssq; __syncthreads();
            float tot = 0.f; for (int w = 0; w < 8; ++w) tot += red[w];
            const float rstd = 1.f / sqrtf(tot * (1.f / DM) + EPS); float d = 0.f;
            for (int q = 0; q < 4; ++q) { const int n_ = F.wave * 256 + q * 64 + F.lane; d = fmaxf(d, fabsf(z[q] * rstd * args.final_gain[n_] - args.out[(size_t)m_ * DM + n_])); }
#pragma unroll
            for (int o = 1; o < 64; o <<= 1) d = fmaxf(d, __shfl_xor(d, o));
            if (F.lane == 0) atomicMax((unsigned*)(F.ctl + 8), __float_as_uint(d));
        }
#endif
    }
    xcd_barrier(bar);
    if (blockIdx.x == 0 && F.tid == 0) {
#if DBG_WHAT == 0 || DBG_WHAT == 6 || DBG_WHAT == 7
        args.out[0] += 10000.f * __uint_as_float(__hip_atomic_load((unsigned*)(F.ctl + 8), __ATOMIC_RELAXED, __HIP_MEMORY_SCOPE_AGENT));
#elif DBG_WHAT == 3
        args.out[0] += 100000.f * __uint_as_float(__hip_atomic_load((unsigned*)(F.ctl + 9), __ATOMIC_RELAXED, __HIP_MEMORY_SCOPE_AGENT));
#elif DBG_WHAT == 4
        args.out[0] += 10.f * (float)__hip_atomic_load((unsigned*)(F.ctl + 10), __ATOMIC_RELAXED, __HIP_MEMORY_SCOPE_AGENT);
#elif DBG_WHAT == 5
        args.out[0] += 10.f * (float)__hip_atomic_load((unsigned*)(F.ctl + 11), __ATOMIC_RELAXED, __HIP_MEMORY_SCOPE_AGENT);
#endif
    }
#endif
}

extern "C" void kernel_launch(void* const* d_in, const int* in_sizes, int n_in, void* d_out, int out_size, void* d_ws, size_t ws_size, hipStream_t stream) {
    static int grid = 0;
    if (grid == 0) {
        if (n_in != 6 || in_sizes[0] != M * DM || in_sizes[2] != DM * D_IN || out_size != M * DM || ws_size < WS_END) {
            fprintf(stderr, "kernel_launch: unexpected shapes / workspace (n_in %d, ws %zu); nothing launched\n", n_in, ws_size); grid = -1; return; }
        int dev = 0, cus = 0;
        if (hipGetDevice(&dev) != hipSuccess || hipDeviceGetAttribute(&cus, hipDeviceAttributeMultiprocessorCount, dev) != hipSuccess) { grid = -1; return; }
        if (hipFuncSetAttribute((const void*)skel_fwd, hipFuncAttributeMaxDynamicSharedMemorySize, LDS_BYTES) != hipSuccess) { fprintf(stderr, "kernel_launch: hipFuncSetAttribute failed\n"); grid = -1; return; }
        (void)hipGetLastError();
        grid = cus < 256 ? cus : 256;
    }
    if (grid < 0) return;
    if (hipMemsetAsync((char*)d_ws + WS_CTL, 0, CTL_ZERO_BYTES, stream) != hipSuccess) return;
    Args a{};
    a.x = (const float*)d_in[0]; a.norm_gain = (const float*)d_in[1]; a.w_in = (const float*)d_in[2]; a.rel_bias = (const float*)d_in[3];
    a.w_out = (const float*)d_in[4]; a.final_gain = (const float*)d_in[5]; a.out = (float*)d_out; a.ws = (unsigned char*)d_ws;
    hipLaunchKernelGGL(skel_fwd, dim3(grid), dim3(NWAVES * 64), LDS_BYTES, stream, a);
}
```
